# Optimizing an MI355X kernel written in HIP

```python
import jax, jax.numpy as jnp
from jax import lax
import numpy as np

D_MODEL = 2048
BATCH = 2
SEQ = 4096
DEPTH = 2

N_A_LAYERS = DEPTH // 2
N_B_LAYERS = DEPTH - N_A_LAYERS

CHUNK = 128
A_EXPAND = 2
A_WIDTH = A_EXPAND * D_MODEL
A_GROUPS = 8
A_GROUP_DIM = A_WIDTH // A_GROUPS

B_HEADS = 16
B_HEAD_DIM = D_MODEL // B_HEADS
B_WIDTH = B_HEADS * B_HEAD_DIM
Q_BLOCK = 128

DN_ALPHA = (2.0 * DEPTH) ** 0.25
DN_BETA = (8.0 * DEPTH) ** -0.25
LN_EPS = 1e-5

kernel_name = "yoco_gmlp_stickbreaking_deepnorm"


def layer_norm(x, g, b):
    xf = x.astype(jnp.float32)
    mu = jnp.mean(xf, axis=-1, keepdims=True)
    xc = xf - mu
    var = jnp.mean(xc * xc, axis=-1, keepdims=True)
    y = xc * lax.rsqrt(var + LN_EPS) * g.astype(jnp.float32) + b.astype(jnp.float32)
    return y.astype(x.dtype)


def gmlp_mixer(x, w_in, b_in, vln_g, vln_b, w_s, b_s, w_out):
    bsz, seq, _ = x.shape
    h = x @ w_in + b_in
    u, v, g = jnp.split(h, 3, axis=-1)
    u = jax.nn.gelu(u)
    v = layer_norm(jax.nn.gelu(v), vln_g, vln_b)
    n_chunks = seq // CHUNK
    v = v.reshape(bsz, n_chunks, CHUNK, A_GROUPS, A_GROUP_DIM)
    causal = jnp.tril(jnp.ones((CHUNK, CHUNK), dtype=bool))
    w = jnp.where(causal[None], w_s, jnp.zeros_like(w_s))
    mixed = jnp.einsum('gts,bcsge->bctge', w, v) + b_s.T[None, None, :, :, None]
    s = u * mixed.reshape(bsz, seq, A_WIDTH)
    return (s * jax.nn.silu(g)) @ w_out


def stick_breaking_attention(q, k, v):
    seq = q.shape[2]
    scale = B_HEAD_DIM ** -0.5
    outs = []
    for blk in range(seq // Q_BLOCK):
        q0 = blk * Q_BLOCK
        kend = q0 + Q_BLOCK
        qb = q[:, :, q0:kend].astype(jnp.float32)
        kb = k[:, :, :kend].astype(jnp.float32)
        vb = v[:, :, :kend].astype(jnp.float32)
        z = jnp.einsum('bhtd,bhsd->bhts', qb, kb) * scale
        t_idx = q0 + jnp.arange(Q_BLOCK)[:, None]
        s_idx = jnp.arange(kend)[None, :]
        past = s_idx < t_idx
        log_keep = jnp.where(past, -jax.nn.softplus(z), 0.0)
        after = lax.cumsum(log_keep, axis=log_keep.ndim - 1, reverse=True) - log_keep
        log_w = jax.nn.log_sigmoid(z) + after
        wts = jnp.where(past, jnp.exp(log_w), 0.0)
        outs.append(jnp.einsum('bhts,bhsd->bhtd', wts, vb))
    return jnp.concatenate(outs, axis=2)


def stick_breaking_mixer(x, k, v, w_in, w_out):
    bsz, seq, _ = x.shape
    h = x @ w_in
    q, g = jnp.split(h, 2, axis=-1)
    q = q.reshape(bsz, seq, B_HEADS, B_HEAD_DIM).transpose(0, 2, 1, 3)
    o = stick_breaking_attention(q, k, v).astype(x.dtype)
    o = o.transpose(0, 2, 1, 3).reshape(bsz, seq, B_WIDTH)
    return (o * jax.nn.silu(g)) @ w_out


def setup_inputs(seed: int = 0) -> dict:
    key = jax.random.key(seed)
    ks = jax.random.split(key, 16)
    f32 = jnp.float32
    x = jax.random.normal(ks[0], (BATCH, SEQ, D_MODEL), f32)
    a_w_in = jax.random.normal(ks[1], (N_A_LAYERS, D_MODEL, 3 * A_WIDTH), f32) * D_MODEL ** -0.5
    a_b_in = 0.02 * jax.random.normal(ks[2], (N_A_LAYERS, 3 * A_WIDTH), f32)
    a_vln_g = 1.0 + 0.02 * jax.random.normal(ks[3], (N_A_LAYERS, A_WIDTH), f32)
    a_vln_b = 0.02 * jax.random.normal(ks[4], (N_A_LAYERS, A_WIDTH), f32)
    a_w_s = jax.random.normal(ks[5], (N_A_LAYERS, A_GROUPS, CHUNK, CHUNK), f32) * CHUNK ** -0.5
    a_b_s = 1.0 + 0.02 * jax.random.normal(ks[6], (N_A_LAYERS, A_GROUPS, CHUNK), f32)
    a_w_out = jax.random.normal(ks[7], (N_A_LAYERS, A_WIDTH, D_MODEL), f32) * (A_WIDTH ** -0.5 * DN_BETA)
    kv_w = jax.random.normal(ks[8], (D_MODEL, 2 * B_WIDTH), f32) * D_MODEL ** -0.5
    b_w_in = jax.random.normal(ks[9], (N_B_LAYERS, D_MODEL, 2 * B_WIDTH), f32) * D_MODEL ** -0.5
    b_w_out = jax.random.normal(ks[10], (N_B_LAYERS, B_WIDTH, D_MODEL), f32) * (B_WIDTH ** -0.5 * DN_BETA)
    ln_g = 1.0 + 0.02 * jax.random.normal(ks[11], (DEPTH, D_MODEL), f32)
    ln_b = 0.02 * jax.random.normal(ks[12], (DEPTH, D_MODEL), f32)
    return {"x": x, "a_w_in": a_w_in, "a_b_in": a_b_in, "a_vln_g": a_vln_g, "a_vln_b": a_vln_b,
            "a_w_s": a_w_s, "a_b_s": a_b_s, "a_w_out": a_w_out, "kv_w": kv_w,
            "b_w_in": b_w_in, "b_w_out": b_w_out, "ln_g": ln_g, "ln_b": ln_b}


def reference(x, a_w_in, a_b_in, a_vln_g, a_vln_b, a_w_s, a_b_s, a_w_out, kv_w,
              b_w_in, b_w_out, ln_g, ln_b):
    bsz, seq, _ = x.shape
    k = None
    v = None
    for layer in range(DEPTH):
        if layer < N_A_LAYERS:
            i = layer
            y = gmlp_mixer(x, a_w_in[i], a_b_in[i], a_vln_g[i], a_vln_b[i],
                           a_w_s[i], a_b_s[i], a_w_out[i])
        else:
            if layer == N_A_LAYERS:
                kv = x @ kv_w
                k, v = jnp.split(kv, 2, axis=-1)
                k = k.reshape(bsz, seq, B_HEADS, B_HEAD_DIM).transpose(0, 2, 1, 3)
                v = v.reshape(bsz, seq, B_HEADS, B_HEAD_DIM).transpose(0, 2, 1, 3)
            j = layer - N_A_LAYERS
            y = stick_breaking_mixer(x, k, v, b_w_in[j], b_w_out[j])
        x = layer_norm(DN_ALPHA * x + y, ln_g[layer], ln_b[layer])
    return x
```

```cpp
#include <hip/hip_runtime.h>
#include <hip/hip_cooperative_groups.h>
#include <cstdio>
#include <cstdint>
namespace cg = cooperative_groups;
namespace pg8 {
#define PG8_LAS __attribute__((address_space(3)))
typedef unsigned short bf16_t;
typedef short bf16x8 __attribute__((ext_vector_type(8)));
typedef float f32x4 __attribute__((ext_vector_type(4)));
typedef unsigned u32x4 __attribute__((ext_vector_type(4)));
constexpr int BM = 256, BK = 64, HALF = 128, HTB = HALF * BK * 2  , STAGE_BYTES = 8 * HTB, NXCD = 8, WGM = 8;

__host__ __device__ __forceinline__ int lds_byte(int r, int c) { const int st = (r >> 4) * 2 + (c >> 5), rr = r & 15, cc = c & 31, ob = rr * 64 + cc * 2; return st * 1024 + (ob ^ (((ob >> 9) & 1) << 5)); }
__host__ __device__ __forceinline__ void stage_rc(int b, int& R, int& C) { const int st = b / 1024, sb = b % 1024, swz = sb ^ (((sb >> 9) & 1) << 5); R = (st >> 1) * 16 + swz / 64; C = (st & 1) * 32 + (swz % 64) / 2; }
__host__ __device__ __forceinline__ int perm32(int rho) { const int n = rho >> 4, i = rho & 15; return 8 * (i >> 2) + 4 * n + (i & 3); }

struct Unit { int pm, pn; };
struct Gemm { const bf16_t* A; const bf16_t* Bt; int M, N, K; };

struct StaticOrder {
    int nM, nN, nwg, G, c;
    __host__ __device__ void init(int M, int N, int G_, int c_) { nM = M / BM; nN = N / BM; nwg = nM * nN; G = G_; c = c_; }
    __host__ __device__ bool next(int i, Unit& u) const {
        const long L = (long)i * G + c; if (L >= nwg) return false;
        int wgid = (int)L; { const int q = nwg / NXCD, r = nwg % NXCD, xcd = wgid % NXCD, off = wgid / NXCD; wgid = (xcd < r ? xcd * (q + 1) : r * (q + 1) + (xcd - r) * q) + off; }
        const int nig = WGM * nN, gid = wgid / nig, fm = gid * WGM, gsz = (nM - fm) < WGM ? (nM - fm) : WGM;
        u.pm = fm + ((wgid % nig) % gsz); u.pn = (wgid % nig) / gsz; return true;
    }
    __device__ __forceinline__ void a_ready(const Unit&) const {}
    __device__ __forceinline__ void done(const Unit&) const {}
};

__device__ __forceinline__ unsigned cvt_pk_bf16(float lo, float hi) { unsigned r; asm volatile("v_cvt_pk_bf16_f32 %0, %1, %2" : "=v"(r) : "v"(lo), "v"(hi)); return r; }
typedef float f32x2 __attribute__((ext_vector_type(2)));
template <class Epi, class Sched, bool ALIGN_EPI = false, bool SP2 = false>
__device__ __forceinline__ void gemm_phase(PG8_LAS unsigned char* lds, const Gemm g, const Sched& S, const Epi& E) {
    const int tid = threadIdx.x, wid = __builtin_amdgcn_readfirstlane(tid >> 6), lane = tid & 63, wr = wid >> 2, wc = wid & 3, fr = lane & 15, fq = lane >> 4;
    const int K = g.K, nt = K / BK;
    unsigned voffA[2], voffB[2];
#pragma unroll
    for (int i = 0; i < 2; ++i) { int R, C; stage_rc(tid * 16 + i * 8192, R, C); const int Rb = Epi::PERM ? ((R & ~31) + perm32(R & 31)) : R;
        voffA[i] = (unsigned)(R * K + C) * 2u; voffB[i] = (unsigned)(Rb * K + C) * 2u; }
    const size_t kstep = (size_t)(BK * 2);
    const size_t hstep = (size_t)HALF * K * 2;
    const size_t tstep = 2 * hstep;
    const unsigned ldsw = (unsigned)wid * 1024u;
    const int aoff = lds_byte(wr * 64 + fr, fq * 8), boff = lds_byte(wc * 32 + fr, fq * 8);
#define PG8_SA(b, h) (((b) * 2 + (h)) * HTB)
#define PG8_SB(b, h) ((4 + (b) * 2 + (h)) * HTB)
#define PG8_STAGE(bufoff, gbase, voff) do { _Pragma("unroll") for (int _i = 0; _i < 2; ++_i) \
        __builtin_amdgcn_global_load_lds((const unsigned*)((const char*)(gbase) + (voff)[_i]), (PG8_LAS unsigned*)(lds + (bufoff) + ldsw + _i * 8192), 16, 0, 0); } while (0)
#define PG8_LDA(dst, b, h) do { _Pragma("unroll") for (int m = 0; m < 4; ++m) _Pragma("unroll") for (int k = 0; k < 2; ++k) dst[m][k] = *(const PG8_LAS bf16x8*)(lds + PG8_SA(b, h) + aoff + m * 2048 + k * 1024); } while (0)
#define PG8_LDB(dst, b, h) do { _Pragma("unroll") for (int n = 0; n < 2; ++n) _Pragma("unroll") for (int k = 0; k < 2; ++k) dst[n][k] = *(const PG8_LAS bf16x8*)(lds + PG8_SB(b, h) + boff + n * 2048 + k * 1024); } while (0)
#define PG8_MMA(ai, bj, At, Bt) do { __builtin_amdgcn_s_setprio(1); _Pragma("unroll") for (int m = 0; m < 4; ++m) _Pragma("unroll") for (int n = 0; n < 2; ++n) _Pragma("unroll") for (int k = 0; k < 2; ++k) \
        acc[ai][bj][m][n] = __builtin_amdgcn_mfma_f32_16x16x32_bf16(Bt[n][k], At[m][k], acc[ai][bj][m][n], 0, 0, 0); __builtin_amdgcn_s_setprio(0); } while (0)
#define PG8_WAIT_V(n) asm volatile("s_waitcnt vmcnt(" #n ")" ::: "memory")
#define PG8_WAIT_L(n) asm volatile("s_waitcnt lgkmcnt(" #n ")" ::: "memory")
#define PG8_BAR __builtin_amdgcn_s_barrier()
#define PG8_SCHED __builtin_amdgcn_sched_barrier(0)
    Unit cur, nxt; int ui = 0;
    if (!S.next(0, cur)) return;
    f32x4 acc[2][2][4][2];
#pragma unroll
    for (int a = 0; a < 2; ++a)
#pragma unroll
        for (int b = 0; b < 2; ++b)
#pragma unroll
            for (int m = 0; m < 4; ++m)
#pragma unroll
                for (int n = 0; n < 2; ++n) acc[a][b][m][n] = (f32x4){0.f, 0.f, 0.f, 0.f};
    bf16x8 At[4][2], B0[2][2], B1[2][2];
    const char* cA = (const char*)g.A + (size_t)cur.pm * tstep; const char* cB = (const char*)g.Bt + (size_t)cur.pn * tstep;
    S.a_ready(cur);
    if constexpr (SP2) {
        PG8_STAGE(PG8_SB(0, 0), cB, voffB); PG8_STAGE(PG8_SB(0, 1), cB + hstep, voffB); PG8_STAGE(PG8_SA(0, 0), cA, voffA); PG8_STAGE(PG8_SA(0, 1), cA + hstep, voffA);
        if (wr == 1) PG8_BAR;
        PG8_WAIT_V(2); PG8_BAR;
        PG8_STAGE(PG8_SB(1, 0), cB + kstep, voffB); PG8_STAGE(PG8_SA(1, 0), cA + kstep, voffA); PG8_STAGE(PG8_SB(1, 1), cB + hstep + kstep, voffB);
        PG8_WAIT_V(6); PG8_BAR;
    } else {
        PG8_STAGE(PG8_SB(0, 0), cB, voffB); PG8_STAGE(PG8_SA(0, 0), cA, voffA); PG8_STAGE(PG8_SB(0, 1), cB + hstep, voffB); PG8_STAGE(PG8_SA(0, 1), cA + hstep, voffA);
        if (wr == 1) PG8_BAR;
        PG8_WAIT_V(4); PG8_BAR;
        PG8_STAGE(PG8_SB(1, 0), cB + kstep, voffB); PG8_STAGE(PG8_SA(1, 0), cA + kstep, voffA); PG8_STAGE(PG8_SB(1, 1), cB + hstep + kstep, voffB);
        PG8_WAIT_V(6); PG8_BAR;
    }
    for (;;) {
        const bool has_next = S.next(ui + 1, nxt);
        const char* nA = has_next ? (const char*)g.A + (size_t)nxt.pm * tstep : cA; const char* nB = has_next ? (const char*)g.Bt + (size_t)nxt.pn * tstep : cB;
        for (int t = 0; t < nt; t += 2) {
            const bool last = (t == nt - 2);
            const char* a1 = cA + (size_t)(t + 1) * kstep;
            const char* a2 = last ? nA : cA + (size_t)(t + 2) * kstep; const char* b2 = last ? nB : cB + (size_t)(t + 2) * kstep;
            const char* a3 = a2 + kstep; const char* b3 = b2 + kstep;
            if (last && has_next) S.a_ready(nxt);
            if constexpr (SP2) {
            PG8_LDB(B0, 0, 0); PG8_LDB(B1, 0, 1); PG8_SCHED; PG8_LDA(At, 0, 0); PG8_STAGE(PG8_SA(1, 1), a1 + hstep, voffA);
            PG8_WAIT_V(8); PG8_WAIT_L(0); PG8_BAR; PG8_MMA(0, 0, At, B0); PG8_MMA(0, 1, At, B1); PG8_BAR; PG8_SCHED;
            PG8_LDA(At, 0, 1); PG8_STAGE(PG8_SB(0, 0), b2, voffB); PG8_STAGE(PG8_SB(0, 1), b2 + hstep, voffB); PG8_STAGE(PG8_SA(0, 0), a2, voffA);
            PG8_WAIT_V(8); PG8_WAIT_L(0); PG8_BAR; PG8_MMA(1, 0, At, B0); PG8_MMA(1, 1, At, B1); PG8_BAR; PG8_SCHED;
            PG8_LDB(B0, 1, 0); PG8_LDB(B1, 1, 1); PG8_SCHED; PG8_LDA(At, 1, 0); PG8_STAGE(PG8_SA(0, 1), a2 + hstep, voffA);
            PG8_WAIT_V(8); PG8_WAIT_L(0); PG8_BAR; PG8_MMA(0, 0, At, B0); PG8_MMA(0, 1, At, B1); PG8_BAR; PG8_SCHED;
            PG8_LDA(At, 1, 1); PG8_STAGE(PG8_SB(1, 0), b3, voffB); PG8_STAGE(PG8_SB(1, 1), b3 + hstep, voffB); PG8_STAGE(PG8_SA(1, 0), a3, voffA);
            PG8_WAIT_V(8); PG8_WAIT_L(0); PG8_BAR; PG8_MMA(1, 0, At, B0); PG8_MMA(1, 1, At, B1); PG8_BAR; PG8_SCHED;
            } else {
            PG8_LDB(B0, 0, 0); PG8_SCHED; PG8_LDA(At, 0, 0); PG8_STAGE(PG8_SA(1, 1), a1 + hstep, voffA);
            PG8_WAIT_L(8); PG8_BAR; PG8_WAIT_L(0); PG8_MMA(0, 0, At, B0); PG8_BAR; PG8_SCHED;
            PG8_LDB(B1, 0, 1); PG8_STAGE(PG8_SB(0, 0), b2, voffB);
            PG8_BAR; PG8_WAIT_L(0); PG8_MMA(0, 1, At, B1); PG8_BAR;
            PG8_LDA(At, 0, 1); PG8_STAGE(PG8_SA(0, 0), a2, voffA);
            PG8_BAR; PG8_WAIT_L(0); PG8_MMA(1, 0, At, B0); PG8_BAR; PG8_SCHED;
            PG8_STAGE(PG8_SB(0, 1), b2 + hstep, voffB);
            PG8_WAIT_V(6); PG8_BAR; PG8_MMA(1, 1, At, B1); PG8_BAR;
            PG8_LDB(B0, 1, 0); PG8_SCHED; PG8_LDA(At, 1, 0); PG8_STAGE(PG8_SA(0, 1), a2 + hstep, voffA);
            PG8_WAIT_L(8); PG8_BAR; PG8_WAIT_L(0); PG8_MMA(0, 0, At, B0); PG8_BAR; PG8_SCHED;
            PG8_LDB(B1, 1, 1); PG8_STAGE(PG8_SB(1, 0), b3, voffB);
            PG8_BAR; PG8_WAIT_L(0); PG8_MMA(0, 1, At, B1); PG8_BAR;
            PG8_LDA(At, 1, 1); PG8_STAGE(PG8_SA(1, 0), a3, voffA);
            PG8_BAR; PG8_WAIT_L(0); PG8_MMA(1, 0, At, B0); PG8_BAR; PG8_SCHED;
            PG8_STAGE(PG8_SB(1, 1), b3 + hstep, voffB);
            PG8_WAIT_V(6); PG8_BAR; PG8_MMA(1, 1, At, B1); PG8_BAR;
            }
        }
        if constexpr (ALIGN_EPI) { if (wr == 0) PG8_BAR; }
        if constexpr (!Epi::AFTER_DRAIN) { E(acc, cur, wr, wc, fr, fq); S.done(cur); }
        if (!has_next) break;
#pragma unroll
        for (int a = 0; a < 2; ++a)
#pragma unroll
            for (int b = 0; b < 2; ++b)
#pragma unroll
                for (int m = 0; m < 4; ++m)
#pragma unroll
                    for (int n = 0; n < 2; ++n) acc[a][b][m][n] = (f32x4){0.f, 0.f, 0.f, 0.f};
        cur = nxt; cA = nA; cB = nB; ++ui;
        if constexpr (ALIGN_EPI) { if (wr == 1) PG8_BAR; }
    }
    PG8_WAIT_V(0);
    if constexpr (!ALIGN_EPI) { if (wr == 0) PG8_BAR; }
    PG8_BAR;
    if constexpr (Epi::AFTER_DRAIN) { E.fused(acc, cur, wr, wc, fr, fq, lds, wid, lane); S.done(cur); }
#undef PG8_SA
#undef PG8_SB
#undef PG8_STAGE
#undef PG8_LDA
#undef PG8_LDB
#undef PG8_MMA
#undef PG8_WAIT_V
#undef PG8_WAIT_L
#undef PG8_BAR
#undef PG8_SCHED
}
}

constexpr int DM = 2048, SEQ = 4096, NB = 2, MROWS = NB * SEQ;
constexpr int AW = 4096, NG = 8, GD = 512, CH = 128;
constexpr int NH = 16, HD = 128;
constexpr float LN_EPS = 1e-5f;
constexpr float DN_ALPHA = 1.4142135623730951f;
constexpr float QSCALE = 0.08838834764831845f * 1.4426950408889634f;

#define LAS __attribute__((address_space(3)))
typedef unsigned short bf16;
typedef float f32x4 __attribute__((ext_vector_type(4)));
typedef float f32x2 __attribute__((ext_vector_type(2)));
typedef float f32x16 __attribute__((ext_vector_type(16)));
typedef short bf16x8 __attribute__((ext_vector_type(8)));
typedef short s16x4 __attribute__((ext_vector_type(4)));
typedef unsigned u32x4 __attribute__((ext_vector_type(4)));
typedef unsigned u32x2 __attribute__((ext_vector_type(2)));

__device__ __forceinline__ unsigned cvtpk(float lo, float hi) { unsigned r; asm volatile("v_cvt_pk_bf16_f32 %0, %1, %2" : "=v"(r) : "v"(lo), "v"(hi)); return r; }
__device__ __forceinline__ float bf2f(unsigned short b) { return __uint_as_float(((unsigned)b) << 16); }
__device__ __forceinline__ float gelu_tanh(float x) { const float t = x * (1.f + 0.044715f * x * x) * 2.302208198f; return x * __builtin_amdgcn_rcpf(1.f + __builtin_amdgcn_exp2f(-t)); }
__device__ __forceinline__ float silu_f(float x) { return x * __builtin_amdgcn_rcpf(1.f + __builtin_amdgcn_exp2f(-1.4426950408889634f * x)); }

namespace pg8 {
__device__ __forceinline__ f32x4 gelu4(f32x4 v) { return (f32x4){gelu_tanh(v[0]), gelu_tanh(v[1]), gelu_tanh(v[2]), gelu_tanh(v[3])}; }
__device__ __forceinline__ f32x4 silu4(f32x4 v) { return (f32x4){silu_f(v[0]), silu_f(v[1]), silu_f(v[2]), silu_f(v[3])}; }
struct EpiG1 {
    static constexpr bool PERM = true, AFTER_DRAIN = false;
    bf16_t* base; size_t rstride; float* stats; const float* bias;
    __device__ __forceinline__ void operator()(const f32x4 (&acc)[2][2][4][2], const Unit& u, int wr, int wc, int fr, int fq) const {
        const int region = u.pn >> 4, pnr = u.pn & 15;
        const int col0 = pnr * BM + wc * 32 + 8 * fq, bcol0 = u.pn * BM + wc * 32 + 8 * fq;
        f32x4 bv[2][2];
#pragma unroll
        for (int bj = 0; bj < 2; ++bj)
#pragma unroll
            for (int n = 0; n < 2; ++n) bv[bj][n] = *(const f32x4*)(bias + bcol0 + bj * HALF + 4 * n);
#pragma unroll
        for (int ai = 0; ai < 2; ++ai)
#pragma unroll
            for (int m = 0; m < 4; ++m) {
                const int row = u.pm * BM + ai * HALF + wr * 64 + m * 16 + fr;
                float s = 0.f, ss = 0.f;
#pragma unroll
                for (int bj = 0; bj < 2; ++bj) {
                    f32x4 a0 = acc[ai][bj][m][0] + bv[bj][0], a1 = acc[ai][bj][m][1] + bv[bj][1];
                    if (region == 2) { a0 = silu4(a0); a1 = silu4(a1); } else { a0 = gelu4(a0); a1 = gelu4(a1); }
                    u32x4 w; w.x = cvtpk(a0[0], a0[1]); w.y = cvtpk(a0[2], a0[3]); w.z = cvtpk(a1[0], a1[1]); w.w = cvtpk(a1[2], a1[3]);
                    if (region == 1) {
                        s += ((a0[0] + a0[1]) + (a0[2] + a0[3])) + ((a1[0] + a1[1]) + (a1[2] + a1[3]));
                        ss += ((a0[0] * a0[0] + a0[1] * a0[1]) + (a0[2] * a0[2] + a0[3] * a0[3])) + ((a1[0] * a1[0] + a1[1] * a1[1]) + (a1[2] * a1[2] + a1[3] * a1[3]));
                        bf16_t* tp = base + rstride + ((size_t)(row >> 7) * AW + col0 + bj * HALF) * CH + (row & 127);
                        tp[0 * CH] = (bf16_t)(w.x & 0xffffu); tp[1 * CH] = (bf16_t)(w.x >> 16); tp[2 * CH] = (bf16_t)(w.y & 0xffffu); tp[3 * CH] = (bf16_t)(w.y >> 16);
                        tp[4 * CH] = (bf16_t)(w.z & 0xffffu); tp[5 * CH] = (bf16_t)(w.z >> 16); tp[6 * CH] = (bf16_t)(w.w & 0xffffu); tp[7 * CH] = (bf16_t)(w.w >> 16);
                    } else {
                        bf16_t* dst = base + (size_t)region * rstride + (size_t)row * AW + col0 + bj * HALF;
                        *(u32x4*)dst = w;
                    }
                }
                if (region == 1) {
                    s += __shfl_xor(s, 16); s += __shfl_xor(s, 32); ss += __shfl_xor(ss, 16); ss += __shfl_xor(ss, 32);
                    if (fq == 0) *(f32x2*)(stats + ((size_t)row * 64 + pnr * 4 + wc) * 2) = (f32x2){s, ss};
                }
            }
    }
};
struct EpiG3 {
    static constexpr bool PERM = true, AFTER_DRAIN = false;
    bf16_t* base; size_t rstride;
    __device__ __forceinline__ void operator()(const f32x4 (&acc)[2][2][4][2], const Unit& u, int wr, int wc, int fr, int fq) const {
        const int region = u.pn >> 3, pnr = u.pn & 7;
        const int col0 = pnr * BM + wc * 32 + 8 * fq;
#pragma unroll
        for (int ai = 0; ai < 2; ++ai)
#pragma unroll
            for (int m = 0; m < 4; ++m) {
                const int row = u.pm * BM + ai * HALF + wr * 64 + m * 16 + fr;
#pragma unroll
                for (int bj = 0; bj < 2; ++bj) {
                    f32x4 a0 = acc[ai][bj][m][0], a1 = acc[ai][bj][m][1];
                    if (region == 3) { a0 = silu4(a0); a1 = silu4(a1); } else if (region == 2) { a0 = a0 * QSCALE; a1 = a1 * QSCALE; }
                    u32x4 w; w.x = cvtpk(a0[0], a0[1]); w.y = cvtpk(a0[2], a0[3]); w.z = cvtpk(a1[0], a1[1]); w.w = cvtpk(a1[2], a1[3]);
                    if (region == 1) {
                        bf16_t* tp = base + rstride + ((size_t)(row >> 12) * DM + col0 + bj * HALF) * SEQ + (row & (SEQ - 1));
                        tp[0 * SEQ] = (bf16_t)(w.x & 0xffffu); tp[1 * SEQ] = (bf16_t)(w.x >> 16); tp[2 * SEQ] = (bf16_t)(w.y & 0xffffu); tp[3 * SEQ] = (bf16_t)(w.y >> 16);
                        tp[4 * SEQ] = (bf16_t)(w.z & 0xffffu); tp[5 * SEQ] = (bf16_t)(w.z >> 16); tp[6 * SEQ] = (bf16_t)(w.w & 0xffffu); tp[7 * SEQ] = (bf16_t)(w.w >> 16);
                    } else {
                        bf16_t* dst = base + (size_t)region * rstride + (size_t)row * DM + col0 + bj * HALF;
                        *(u32x4*)dst = w;
                    }
                }
            }
    }
};
struct EpiRes {
    static constexpr bool PERM = false, AFTER_DRAIN = false;
    const float* X; float* Z;
    __device__ __forceinline__ void operator()(const f32x4 (&acc)[2][2][4][2], const Unit& u, int wr, int wc, int fr, int fq) const {
        const int col0 = u.pn * BM + wc * 32 + 4 * fq;
#pragma unroll
        for (int ai = 0; ai < 2; ++ai)
#pragma unroll
            for (int m = 0; m < 4; ++m) {
                const size_t off = (size_t)(u.pm * BM + ai * HALF + wr * 64 + m * 16 + fr) * DM + col0;
#pragma unroll
                for (int bj = 0; bj < 2; ++bj)
#pragma unroll
                    for (int n = 0; n < 2; ++n) { const f32x4 xv = *(const f32x4*)(X + off + bj * HALF + n * 16); *(f32x4*)(Z + off + bj * HALF + n * 16) = xv * DN_ALPHA + acc[ai][bj][m][n]; }
            }
    }
};
}

constexpr size_t MiB = 1u << 20;
constexpr size_t WS_W2T = 0 * MiB;
constexpr size_t WS_W3T = 16 * MiB;
constexpr size_t WS_W4T = 48 * MiB;
constexpr size_t WS_W1T = 56 * MiB;
constexpr size_t WS_XB  = 104 * MiB;
constexpr size_t WS_SM  = 56 * MiB;
constexpr size_t WS_U   = 136 * MiB;
constexpr size_t WS_GVT = 200 * MiB;
constexpr size_t WS_SG  = 264 * MiB;
constexpr size_t WS_ST  = 328 * MiB;
constexpr size_t WS_Z   = 136 * MiB;
constexpr size_t WS_X1  = 200 * MiB;
constexpr size_t WS_X1B = 264 * MiB;
constexpr size_t WS_KB  = 56 * MiB;
constexpr size_t WS_VT  = 88 * MiB;
constexpr size_t WS_QB  = 120 * MiB;
constexpr size_t WS_SGB = 152 * MiB;
constexpr size_t WS_OG  = 296 * MiB;
constexpr size_t WS_Z2  = 56 * MiB;
constexpr size_t WS_END = 332 * MiB;
static_assert(WS_SG - WS_GVT == WS_GVT - WS_U && WS_VT - WS_KB == WS_QB - WS_VT && WS_SGB - WS_QB == WS_VT - WS_KB, "region strides");

constexpr int LDS_BYTES = 147456;
constexpr int NWAVES = 8;

struct Params {
    const float* x; const float* a_w_in; const float* a_b_in; const float* a_vln_g; const float* a_vln_b; const float* a_w_s; const float* a_b_s; const float* a_w_out;
    const float* kv_w; const float* b_w_in; const float* b_w_out; const float* ln_g; const float* ln_b;
    float* out; unsigned char* ws;
};

__device__ __forceinline__ void p0_transpose_item(const float* W, int K, int N, bf16* WT, int row_off, LAS float* scr, int item, int lane) {
    const int nblk = N / 32, kb = item / nblk, nb = item % nblk, k0 = 64 * kb, n0 = 32 * nb;
#pragma unroll 8
    for (int i = 0; i < 32; ++i) { const int kk = 2 * i + (lane >> 5); scr[kk * 33 + (lane & 31)] = W[(size_t)(k0 + kk) * N + n0 + (lane & 31)]; }
    asm volatile("s_waitcnt lgkmcnt(0)" ::: "memory");
    const int c = lane & 7;
#pragma unroll
    for (int j = 0; j < 4; ++j) { const int n = (lane >> 3) + 8 * j; const LAS float* s = scr + (8 * c) * 33 + n;
        u32x4 o; o.x = cvtpk(s[0 * 33], s[1 * 33]); o.y = cvtpk(s[2 * 33], s[3 * 33]); o.z = cvtpk(s[4 * 33], s[5 * 33]); o.w = cvtpk(s[6 * 33], s[7 * 33]);
        *(u32x4*)(WT + (size_t)(row_off + n0 + n) * K + k0 + 8 * c) = o; }
    asm volatile("s_waitcnt lgkmcnt(0)" ::: "memory");
}
__device__ __forceinline__ void p0_phase(LAS unsigned char* lds, const Params& p, int G) {
    const int tid = threadIdx.x, lane = tid & 63, wave = tid >> 6;
    LAS float* scr = (LAS float*)(lds + wave * 16384);
    const int gw = blockIdx.x * NWAVES + wave, NGW = G * NWAVES;
    constexpr int I_1 = (DM / 64) * (3 * AW / 32), I_2 = (AW / 64) * (DM / 32), I_KV = (DM / 64) * (2 * DM / 32), I_BI = I_KV, I_BO = (DM / 64) * (DM / 32);
    constexpr int NITEMS = I_1 + I_2 + I_KV + I_BI + I_BO;
    bf16* W1T = (bf16*)(p.ws + WS_W1T); bf16* W2T = (bf16*)(p.ws + WS_W2T); bf16* W3T = (bf16*)(p.ws + WS_W3T); bf16* W4T = (bf16*)(p.ws + WS_W4T);
    for (int it = gw; it < NITEMS; it += NGW) {
        int r = it;
        if (r < I_1) { p0_transpose_item(p.a_w_in, DM, 3 * AW, W1T, 0, scr, r, lane); continue; } r -= I_1;
        if (r < I_2) { p0_transpose_item(p.a_w_out, AW, DM, W2T, 0, scr, r, lane); continue; } r -= I_2;
        if (r < I_KV) { p0_transpose_item(p.kv_w, DM, 2 * DM, W3T, 0, scr, r, lane); continue; } r -= I_KV;
        if (r < I_BI) { p0_transpose_item(p.b_w_in, DM, 2 * DM, W3T, 2 * DM, scr, r, lane); continue; } r -= I_BI;
        p0_transpose_item(p.b_w_out, DM, DM, W4T, 0, scr, r, lane);
    }
    bf16* XB = (bf16*)(p.ws + WS_XB);
    const size_t n8 = (size_t)MROWS * DM / 8;
    for (size_t i = (size_t)blockIdx.x * 512 + tid; i < n8; i += (size_t)G * 512) {
        const f32x4 a = *(const f32x4*)(p.x + i * 8), b = *(const f32x4*)(p.x + i * 8 + 4);
        u32x4 o; o.x = cvtpk(a[0], a[1]); o.y = cvtpk(a[2], a[3]); o.z = cvtpk(b[0], b[1]); o.w = cvtpk(b[2], b[3]);
        *(u32x4*)(XB + i * 8) = o;
    }
}

__device__ __forceinline__ void mix_phase(LAS unsigned char* lds, const Params& p, int job_lo, int job_step) {
    constexpr int TP = 272;
    constexpr int OFF_A = 0, OFF_B = 128 * TP, OFF_MU = 2 * 128 * TP, OFF_RS = OFF_MU + 512, OFF_C1 = OFF_RS + 512, OFF_C2 = OFF_C1 + 512;
    const int tid = threadIdx.x, lane = tid & 63, wid = tid >> 6, wr = wid >> 2, wc = wid & 3, fr = lane & 15, fq = lane >> 4;
    const bf16* U = (const bf16*)(p.ws + WS_U); const bf16* GVt = (const bf16*)(p.ws + WS_GVT); const bf16* SG = (const bf16*)(p.ws + WS_SG);
    const float* stats = (const float*)(p.ws + WS_ST); bf16* SM = (bf16*)(p.ws + WS_SM);
    LAS float* mu = (LAS float*)(lds + OFF_MU); LAS float* rs = (LAS float*)(lds + OFF_RS); LAS float* c1s = (LAS float*)(lds + OFF_C1); LAS float* c2s = (LAS float*)(lds + OFF_C2);
    for (int job = job_lo; job < 256; job += job_step) {
        const int chunk = job >> 2, part = job & 3;
        __syncthreads();
        {
            const int row = tid >> 2, q = tid & 3;
            const f32x2* sp = (const f32x2*)stats + ((size_t)(chunk * CH + row) * 64 + q * 16);
            float s = 0.f, ss = 0.f;
#pragma unroll
            for (int i = 0; i < 16; ++i) { const f32x2 v = sp[i]; s += v.x; ss += v.y; }
            s += __shfl_xor(s, 1); s += __shfl_xor(s, 2); ss += __shfl_xor(ss, 1); ss += __shfl_xor(ss, 2);
            const float mean = s * (1.f / AW), var = ss * (1.f / AW) - mean * mean;
            if (q == 0) { mu[row] = mean; rs[row] = 1.0f / sqrtf(var + LN_EPS); }
        }
        __syncthreads();
        for (int gi = 0; gi < 2; ++gi) {
            const int g = part * 2 + gi;
            __syncthreads();
            {
                const int t = tid >> 2, q = tid & 3;
                const float* wrow = p.a_w_s + ((size_t)g * CH + t) * CH + q * 32;
                float c1 = 0.f, c2 = 0.f;
#pragma unroll
                for (int i = 0; i < 4; ++i) {
                    const f32x4 w0 = *(const f32x4*)(wrow + i * 8), w1 = *(const f32x4*)(wrow + i * 8 + 4);
                    float w[8] = {w0[0], w0[1], w0[2], w0[3], w1[0], w1[1], w1[2], w1[3]};
                    float wp[8];
#pragma unroll
                    for (int j = 0; j < 8; ++j) { const int s = q * 32 + i * 8 + j; const float wm = (s <= t) ? w[j] : 0.f; c2 += wm; wp[j] = wm * rs[s]; }
                    u32x4 o; o.x = cvtpk(wp[0], wp[1]); o.y = cvtpk(wp[2], wp[3]); o.z = cvtpk(wp[4], wp[5]); o.w = cvtpk(wp[6], wp[7]);
#pragma unroll
                    for (int j = 0; j < 4; ++j) { const unsigned pk = o[j]; const int s = q * 32 + i * 8 + 2 * j; c1 += __uint_as_float(pk << 16) * mu[s] + __uint_as_float(pk & 0xffff0000u) * mu[s + 1]; }
                    *(LAS u32x4*)(lds + OFF_A + t * TP + (q * 32 + i * 8) * 2) = o;
                }
                c1 += __shfl_xor(c1, 1); c1 += __shfl_xor(c1, 2); c2 += __shfl_xor(c2, 1); c2 += __shfl_xor(c2, 2);
                if (q == 0) { c1s[t] = c1; c2s[t] = c2; }
            }
            for (int eb = 0; eb < 4; ++eb) {
                const int ecol0 = g * GD + eb * 128;
                __syncthreads();
                {
                    const int er = tid >> 2, pc = tid & 3;
                    const bf16* src = GVt + ((size_t)chunk * AW + ecol0 + er) * CH + pc * 32;
                    const u32x4 b0 = *(const u32x4*)(src), b1 = *(const u32x4*)(src + 8), b2 = *(const u32x4*)(src + 16), b3 = *(const u32x4*)(src + 24);
                    LAS unsigned char* d = lds + OFF_B + er * TP + pc * 64;
                    *(LAS u32x4*)(d) = b0; *(LAS u32x4*)(d + 16) = b1; *(LAS u32x4*)(d + 32) = b2; *(LAS u32x4*)(d + 48) = b3;
                }
                __syncthreads();
                f32x4 acc[4][2];
#pragma unroll
                for (int m = 0; m < 4; ++m)
#pragma unroll
                    for (int n = 0; n < 2; ++n) acc[m][n] = (f32x4){0.f, 0.f, 0.f, 0.f};
#pragma unroll
                for (int k = 0; k < 4; ++k) {
                    bf16x8 af[4], bfr[2];
#pragma unroll
                    for (int m = 0; m < 4; ++m) af[m] = *(const LAS bf16x8*)(lds + OFF_A + (wr * 64 + m * 16 + fr) * TP + (k * 32 + fq * 8) * 2);
#pragma unroll
                    for (int n = 0; n < 2; ++n) { const int erow = wc * 32 + 8 * (fr >> 2) + 4 * n + (fr & 3); bfr[n] = *(const LAS bf16x8*)(lds + OFF_B + erow * TP + (k * 32 + fq * 8) * 2); }
#pragma unroll
                    for (int m = 0; m < 4; ++m)
#pragma unroll
                        for (int n = 0; n < 2; ++n) acc[m][n] = __builtin_amdgcn_mfma_f32_16x16x32_bf16(bfr[n], af[m], acc[m][n], 0, 0, 0);
                }
                const int ec = ecol0 + wc * 32 + 8 * fq;
                const f32x4 g0 = *(const f32x4*)(p.a_vln_g + ec), g1 = *(const f32x4*)(p.a_vln_g + ec + 4), be0 = *(const f32x4*)(p.a_vln_b + ec), be1 = *(const f32x4*)(p.a_vln_b + ec + 4);
#pragma unroll
                for (int m = 0; m < 4; ++m) {
                    const int t = wr * 64 + m * 16 + fr; const size_t off = (size_t)(chunk * CH + t) * AW + ec;
                    const float c1 = c1s[t], c2 = c2s[t], bs = p.a_b_s[g * CH + t];
                    const u32x4 uu = *(const u32x4*)(U + off), sg = *(const u32x4*)(SG + off);
                    const f32x4 m0 = g0 * (acc[m][0] - c1) + be0 * c2 + bs, m1 = g1 * (acc[m][1] - c1) + be1 * c2 + bs;
                    float r[8];
#pragma unroll
                    for (int j = 0; j < 4; ++j) {
                        const float mlo = (j < 2) ? m0[2 * j] : m1[2 * j - 4], mhi = (j < 2) ? m0[2 * j + 1] : m1[2 * j - 3];
                        r[2 * j] = __uint_as_float(uu[j] << 16) * mlo * __uint_as_float(sg[j] << 16);
                        r[2 * j + 1] = __uint_as_float(uu[j] & 0xffff0000u) * mhi * __uint_as_float(sg[j] & 0xffff0000u);
                    }
                    u32x4 o; o.x = cvtpk(r[0], r[1]); o.y = cvtpk(r[2], r[3]); o.z = cvtpk(r[4], r[5]); o.w = cvtpk(r[6], r[7]);
                    *(u32x4*)(SM + off) = o;
                }
            }
        }
    }
}

__device__ __forceinline__ void ln_phase(const float* Z, const float* gam, const float* bet, float* Xout, bf16* Xb, int G) {
    const int tid = threadIdx.x, lane = tid & 63, wave = tid >> 6;
    f32x4 gv[8], bv[8];
#pragma unroll
    for (int j = 0; j < 8; ++j) { gv[j] = *(const f32x4*)(gam + (64 * j + lane) * 4); bv[j] = *(const f32x4*)(bet + (64 * j + lane) * 4); }
    for (int row = blockIdx.x * NWAVES + wave; row < MROWS; row += G * NWAVES) {
        const f32x4* zr = (const f32x4*)(Z + (size_t)row * DM) + lane;
        f32x4 v[8]; float s = 0.f;
#pragma unroll
        for (int j = 0; j < 8; ++j) { v[j] = zr[64 * j]; s += (v[j][0] + v[j][1]) + (v[j][2] + v[j][3]); }
#pragma unroll
        for (int o = 1; o < 64; o <<= 1) s += __shfl_xor(s, o);
        const float mean = s * (1.f / DM); float s2 = 0.f;
#pragma unroll
        for (int j = 0; j < 8; ++j) { v[j] = v[j] - mean; s2 += (v[j][0] * v[j][0] + v[j][1] * v[j][1]) + (v[j][2] * v[j][2] + v[j][3] * v[j][3]); }
#pragma unroll
        for (int o = 1; o < 64; o <<= 1) s2 += __shfl_xor(s2, o);
        const float rstd = 1.0f / sqrtf(s2 * (1.f / DM) + LN_EPS);
#pragma unroll
        for (int j = 0; j < 8; ++j) {
            const f32x4 y = v[j] * rstd * gv[j] + bv[j];
            *((f32x4*)(Xout + (size_t)row * DM) + 64 * j + lane) = y;
            if (Xb) { u32x2 w; w.x = cvtpk(y[0], y[1]); w.y = cvtpk(y[2], y[3]); *((u32x2*)(Xb + (size_t)row * DM) + 64 * j + lane) = w; }
        }
    }
}

namespace sba {
constexpr int KP = 272, VP = 136;
constexpr int KSB = 64 * KP, VSB = 128 * VP;
constexpr int OFF_K = 0, OFF_V = 2 * KSB, OFF_FLAG = 2 * KSB + 2 * VSB;
#ifndef SBA_EARLY_EXIT
#define SBA_EARLY_EXIT 1
#endif
__device__ __forceinline__ int crow(int r, int hi) { return (r & 3) + 8 * (r >> 2) + 4 * hi; }
__device__ __forceinline__ void sb_block(f32x16& p, float& c, int kbase, int trow, int hi, bool band) {
    float sfx[16];
#pragma unroll
    for (int r = 0; r < 16; ++r) {
        float e = __builtin_amdgcn_exp2f(__builtin_fminf(p[r], 100.f));
        if (band) { const int key = kbase + crow(r, hi); e = (key < trow) ? e : 0.f; }
        p[r] = e; sfx[r] = 1.f + e;
    }
    float lo[4], hh[4];
#pragma unroll
    for (int k = 0; k < 4; ++k) {
        sfx[4 * k + 2] *= sfx[4 * k + 3]; sfx[4 * k + 1] *= sfx[4 * k + 2]; sfx[4 * k] *= sfx[4 * k + 1];
        const unsigned tb = __float_as_uint(sfx[4 * k]);
        auto rr = __builtin_amdgcn_permlane32_swap(tb, tb, false, false);
        lo[k] = __uint_as_float(rr[0]); hh[k] = __uint_as_float(rr[1]);
    }
    float E[4];
#pragma unroll
    for (int k = 3; k >= 0; --k) { const float eh = c; c *= hh[k]; const float el = c; c *= lo[k]; E[k] = hi ? eh : el; }
#pragma unroll
    for (int r = 0; r < 16; ++r) p[r] = p[r] * __builtin_amdgcn_rcpf(sfx[r] * E[r >> 2]);
}
__device__ __forceinline__ void attn_unit(LAS unsigned char* lds, int b, int h, int qb, const bf16* Qb, const bf16* Kb, const bf16* Vt, const bf16* SGb, bf16* OG) {
    const int tid = threadIdx.x, lane = tid & 63, r32 = lane & 31, hi = lane >> 5;
    const int wid = __builtin_amdgcn_readfirstlane(tid >> 6);
    const int t0 = qb * 256, tw0 = t0 + wid * 32, trow = tw0 + r32;
    const size_t rowbase = (size_t)b * SEQ;
    bf16x8 qr[8];
    { const bf16* qp = Qb + (rowbase + trow) * DM + h * HD + hi * 8;
#pragma unroll
      for (int d0 = 0; d0 < 8; ++d0) qr[d0] = *(const bf16x8*)(qp + d0 * 16); }
    f32x16 o[4];
#pragma unroll
    for (int i = 0; i < 4; ++i)
#pragma unroll
        for (int r = 0; r < 16; ++r) o[i][r] = 0.f;
    float R = 1.f;
    const int krow = tid >> 3, kpc = tid & 7, vrow = tid >> 2, vpc = tid & 3;
    const bf16* kg = Kb + (rowbase + krow) * DM + h * HD + kpc * 16;
    const bf16* vg = Vt + ((size_t)(b * NH + h) * HD + vrow) * SEQ + vpc * 16;
    LAS unsigned char* kdst = lds + OFF_K + krow * KP + kpc * 32;
    LAS unsigned char* vdst = lds + OFF_V + vrow * VP + vpc * 32;
    LAS unsigned* flags = (LAS unsigned*)(lds + OFF_FLAG);
    const int jmax = 4 * qb + 3;
    u32x4 kr0, kr1, vr0, vr1;
#define SBA_LOAD(j) do { const bf16* kp_ = kg + (size_t)(j) * 64 * DM; kr0 = *(const u32x4*)kp_; kr1 = *(const u32x4*)(kp_ + 8); const bf16* vp_ = vg + (j) * 64; vr0 = *(const u32x4*)vp_; vr1 = *(const u32x4*)(vp_ + 8); } while (0)
#define SBA_STORE(bf) do { LAS unsigned char* kd_ = kdst + (bf) * KSB; *(LAS u32x4*)kd_ = kr0; *(LAS u32x4*)(kd_ + 16) = kr1; LAS unsigned char* vd_ = vdst + (bf) * VSB; \
        *(LAS u32x2*)vd_ = (u32x2){vr0.x, vr0.y}; *(LAS u32x2*)(vd_ + 8) = (u32x2){vr0.z, vr0.w}; *(LAS u32x2*)(vd_ + 16) = (u32x2){vr1.x, vr1.y}; *(LAS u32x2*)(vd_ + 24) = (u32x2){vr1.z, vr1.w}; } while (0)
    SBA_LOAD(jmax); SBA_STORE(0);
    __syncthreads();
    bool wdone = false;
    for (int j = jmax, it = 0;; --j, ++it) {
        const int buf = it & 1;
        if (j > 0) SBA_LOAD(j - 1);
        const int k0 = 64 * j;
        if (k0 < tw0 + 32 && !wdone) {
            const LAS unsigned char* kb = lds + OFF_K + buf * KSB + r32 * KP + hi * 16;
            f32x16 p0, p1;
#pragma unroll
            for (int r = 0; r < 16; ++r) { p0[r] = 0.f; p1[r] = 0.f; }
#pragma unroll
            for (int d0 = 0; d0 < 8; ++d0) {
                const bf16x8 k0f = *(const LAS bf16x8*)(kb + d0 * 32), k1f = *(const LAS bf16x8*)(kb + 32 * KP + d0 * 32);
                p0 = __builtin_amdgcn_mfma_f32_32x32x16_bf16(k0f, qr[d0], p0, 0, 0, 0);
                p1 = __builtin_amdgcn_mfma_f32_32x32x16_bf16(k1f, qr[d0], p1, 0, 0, 0);
            }
            const bool band = (k0 + 63 >= tw0);
            sb_block(p1, R, k0 + 32, trow, hi, band);
            sb_block(p0, R, k0, trow, hi, band);
            bf16x8 pw[4];
            { u32x4 w;
              w.x = cvtpk(p0[0], p0[1]); w.y = cvtpk(p0[2], p0[3]); w.z = cvtpk(p0[4], p0[5]); w.w = cvtpk(p0[6], p0[7]); pw[0] = __builtin_bit_cast(bf16x8, w);
              w.x = cvtpk(p0[8], p0[9]); w.y = cvtpk(p0[10], p0[11]); w.z = cvtpk(p0[12], p0[13]); w.w = cvtpk(p0[14], p0[15]); pw[1] = __builtin_bit_cast(bf16x8, w);
              w.x = cvtpk(p1[0], p1[1]); w.y = cvtpk(p1[2], p1[3]); w.z = cvtpk(p1[4], p1[5]); w.w = cvtpk(p1[6], p1[7]); pw[2] = __builtin_bit_cast(bf16x8, w);
              w.x = cvtpk(p1[8], p1[9]); w.y = cvtpk(p1[10], p1[11]); w.z = cvtpk(p1[12], p1[13]); w.w = cvtpk(p1[14], p1[15]); pw[3] = __builtin_bit_cast(bf16x8, w); }
            const LAS unsigned char* vb = lds + OFF_V + buf * VSB + r32 * VP + hi * 8;
#pragma unroll
            for (int db = 0; db < 4; ++db)
#pragma unroll
                for (int ks = 0; ks < 4; ++ks) {
                    const s16x4 v0 = *(const LAS s16x4*)(vb + db * 32 * VP + ks * 32), v1 = *(const LAS s16x4*)(vb + db * 32 * VP + ks * 32 + 16);
                    const bf16x8 vf = (bf16x8){v0[0], v0[1], v0[2], v0[3], v1[0], v1[1], v1[2], v1[3]};
                    o[db] = __builtin_amdgcn_mfma_f32_32x32x16_bf16(pw[ks], vf, o[db], 0, 0, 0);
                }
#if SBA_EARLY_EXIT
            wdone = __all(R > 1e30f);
#endif
        }
        if (j > 0) SBA_STORE(buf ^ 1);
        if (lane == 0) flags[buf * 8 + wid] = wdone ? 1u : 0u;
        __syncthreads();
        if (j == 0) break;
        unsigned nd = 0;
#pragma unroll
        for (int w = 0; w < 8; ++w) nd += flags[buf * 8 + w];
        if (nd == 8u) break;
    }
#undef SBA_LOAD
#undef SBA_STORE
#pragma unroll
    for (int db = 0; db < 4; ++db)
#pragma unroll
        for (int r = 0; r < 16; ++r) {
            const size_t idx = (rowbase + tw0 + crow(r, hi)) * DM + h * HD + db * 32 + r32;
            const float v = o[db][r] * bf2f(SGb[idx]);
            OG[idx] = (bf16)(cvtpk(v, v) & 0xffffu);
        }
    __syncthreads();
}
}

#ifndef MK_PH_LO
#define MK_PH_LO 0
#endif
#ifndef MK_PH_HI
#define MK_PH_HI 9
#endif
__global__ void __launch_bounds__(NWAVES * 64, 2) yoco_fwd(Params p) {
    extern __shared__ __attribute__((aligned(16))) unsigned char lds_raw[];
    LAS unsigned char* lds = (LAS unsigned char*)lds_raw;
    cg::grid_group grid = cg::this_grid();
    const int G = gridDim.x, bx = blockIdx.x;
    const int vcu = (G % 8 == 0) ? (bx % 8) * (G / 8) + bx / 8 : bx;
    unsigned char* ws = p.ws;
    bf16* W1T = (bf16*)(ws + WS_W1T); bf16* W2T = (bf16*)(ws + WS_W2T); bf16* W3T = (bf16*)(ws + WS_W3T); bf16* W4T = (bf16*)(ws + WS_W4T);

#ifndef PHMASK
#define PHMASK 0x1ff
#endif
    if (PHMASK & 1) p0_phase(lds, p, G);
    grid.sync();
    if (PHMASK & 2) {
        pg8::Gemm g{(const bf16*)(ws + WS_XB), W1T, MROWS, 3 * AW, DM}; pg8::StaticOrder S; S.init(MROWS, 3 * AW, G, bx);
        pg8::EpiG1 E{(bf16*)(ws + WS_U), (size_t)(WS_GVT - WS_U) / 2, (float*)(ws + WS_ST), p.a_b_in};
        pg8::gemm_phase<pg8::EpiG1, pg8::StaticOrder, true, true>(lds, g, S, E);
    }
    grid.sync();
    if (PHMASK & 4) mix_phase(lds, p, bx, G);
    grid.sync();
    if (PHMASK & 8) {
        pg8::Gemm g{(const bf16*)(ws + WS_SM), W2T, MROWS, DM, AW}; pg8::StaticOrder S; S.init(MROWS, DM, G, bx);
        pg8::EpiRes E{p.x, (float*)(ws + WS_Z)};
        pg8::gemm_phase<pg8::EpiRes, pg8::StaticOrder, true, true>(lds, g, S, E);
    }
    grid.sync();
    if (PHMASK & 16) ln_phase((const float*)(ws + WS_Z), p.ln_g, p.ln_b, (float*)(ws + WS_X1), (bf16*)(ws + WS_X1B), G);
    grid.sync();
    if (PHMASK & 32) {
        pg8::Gemm g{(const bf16*)(ws + WS_X1B), W3T, MROWS, 4 * DM, DM}; pg8::StaticOrder S; S.init(MROWS, 4 * DM, G, bx);
        pg8::EpiG3 E{(bf16*)(ws + WS_KB), (size_t)(WS_VT - WS_KB) / 2};
        pg8::gemm_phase<pg8::EpiG3, pg8::StaticOrder, true, true>(lds, g, S, E);
    }
    grid.sync();
    if (PHMASK & 64) {
        for (int v = vcu; v < 256; v += G) {
            const int bh = v >> 3, s = v & 7;
            for (int i = 0; i < 2; ++i)
                sba::attn_unit(lds, bh >> 4, bh & 15, i == 0 ? 15 - s : s, (const bf16*)(ws + WS_QB), (const bf16*)(ws + WS_KB), (const bf16*)(ws + WS_VT), (const bf16*)(ws + WS_SGB), (bf16*)(ws + WS_OG));
        }
    }
    grid.sync();
    if (PHMASK & 128) {
        pg8::Gemm g{(const bf16*)(ws + WS_OG), W4T, MROWS, DM, DM}; pg8::StaticOrder S; S.init(MROWS, DM, G, bx);
        pg8::EpiRes E{(const float*)(ws + WS_X1), (float*)(ws + WS_Z2)};
        pg8::gemm_phase<pg8::EpiRes, pg8::StaticOrder, true, true>(lds, g, S, E);
    }
    grid.sync();
    if (PHMASK & 256) ln_phase((const float*)(ws + WS_Z2), p.ln_g + DM, p.ln_b + DM, p.out, nullptr, G);
}

extern "C" void kernel_launch(void* const* d_in, const int* in_sizes, int n_in, void* d_out, int out_size, void* d_ws, size_t ws_size, hipStream_t stream) {
    static int grid = 0;
    if (grid == 0) {
        if (n_in != 13 || in_sizes[0] != MROWS * DM || out_size != MROWS * DM || ws_size < WS_END) {
            fprintf(stderr, "kernel_launch: shape/workspace mismatch (n_in %d, in0 %d, out %d, ws %zu, need %zu)\n", n_in, n_in > 0 ? in_sizes[0] : -1, out_size, ws_size, (size_t)WS_END); grid = -1; return; }
        int dev = 0, cus = 0, per_cu = 0;
        hipGetDevice(&dev);
        hipDeviceGetAttribute(&cus, hipDeviceAttributeMultiprocessorCount, dev);
        if (hipFuncSetAttribute((const void*)yoco_fwd, hipFuncAttributeMaxDynamicSharedMemorySize, LDS_BYTES) != hipSuccess) { fprintf(stderr, "kernel_launch: hipFuncSetAttribute failed\n"); grid = -1; return; }
        if (hipOccupancyMaxActiveBlocksPerMultiprocessor(&per_cu, (const void*)yoco_fwd, NWAVES * 64, LDS_BYTES) != hipSuccess || per_cu < 1) { fprintf(stderr, "kernel_launch: occupancy query says %d\n", per_cu); per_cu = 1; }
        (void)hipGetLastError();
        grid = cus * (per_cu > 1 ? 1 : per_cu);
    }
    if (grid < 0) return;
    Params p{};
    p.x = (const float*)d_in[0]; p.a_w_in = (const float*)d_in[1]; p.a_b_in = (const float*)d_in[2]; p.a_vln_g = (const float*)d_in[3]; p.a_vln_b = (const float*)d_in[4];
    p.a_w_s = (const float*)d_in[5]; p.a_b_s = (const float*)d_in[6]; p.a_w_out = (const float*)d_in[7]; p.kv_w = (const float*)d_in[8]; p.b_w_in = (const float*)d_in[9];
    p.b_w_out = (const float*)d_in[10]; p.ln_g = (const float*)d_in[11]; p.ln_b = (const float*)d_in[12]; p.out = (float*)d_out; p.ws = (unsigned char*)d_ws;
    void* args[] = {&p};
    const hipError_t e = hipLaunchCooperativeKernel((const void*)yoco_fwd, dim3(grid), dim3(NWAVES * 64), args, LDS_BYTES, stream);
    if (e != hipSuccess) fprintf(stderr, "kernel_launch: cooperative launch failed: %s (grid %d)\n", hipGetErrorString(e), grid);
}
```

```cpp
#include <hip/hip_runtime.h>
#include <hip/hip_cooperative_groups.h>
#include <cstdio>
#include <cstdint>
namespace cg = cooperative_groups;
namespace pg8 {
#define PG8_LAS __attribute__((address_space(3)))
typedef unsigned short bf16_t;
typedef short bf16x8 __attribute__((ext_vector_type(8)));
typedef float f32x4 __attribute__((ext_vector_type(4)));
typedef unsigned u32x4 __attribute__((ext_vector_type(4)));
constexpr int BM = 256, BK = 64, HALF = 128, HTB = HALF * BK * 2  , STAGE_BYTES = 8 * HTB, NXCD = 8, WGM = 8;

__host__ __device__ __forceinline__ int lds_byte(int r, int c) { const int st = (r >> 4) * 2 + (c >> 5), rr = r & 15, cc = c & 31, ob = rr * 64 + cc * 2; return st * 1024 + (ob ^ (((ob >> 9) & 1) << 5)); }
__host__ __device__ __forceinline__ void stage_rc(int b, int& R, int& C) { const int st = b / 1024, sb = b % 1024, swz = sb ^ (((sb >> 9) & 1) << 5); R = (st >> 1) * 16 + swz / 64; C = (st & 1) * 32 + (swz % 64) / 2; }
__host__ __device__ __forceinline__ int perm32(int rho) { const int n = rho >> 4, i = rho & 15; return 8 * (i >> 2) + 4 * n + (i & 3); }

struct Unit { int pm, pn; };
struct Gemm { const bf16_t* A; const bf16_t* Bt; int M, N, K; };

struct StaticOrder {
    int nM, nN, nwg, G, c;
    __host__ __device__ void init(int M, int N, int G_, int c_) { nM = M / BM; nN = N / BM; nwg = nM * nN; G = G_; c = c_; }
    __host__ __device__ bool next(int i, Unit& u) const {
        const long L = (long)i * G + c; if (L >= nwg) return false;
        int wgid = (int)L; { const int q = nwg / NXCD, r = nwg % NXCD, xcd = wgid % NXCD, off = wgid / NXCD; wgid = (xcd < r ? xcd * (q + 1) : r * (q + 1) + (xcd - r) * q) + off; }
        const int nig = WGM * nN, gid = wgid / nig, fm = gid * WGM, gsz = (nM - fm) < WGM ? (nM - fm) : WGM;
        u.pm = fm + ((wgid % nig) % gsz); u.pn = (wgid % nig) / gsz; return true;
    }
    __device__ __forceinline__ void a_ready(const Unit&) const {}
    __device__ __forceinline__ void done(const Unit&) const {}
};

__device__ __forceinline__ unsigned cvt_pk_bf16(float lo, float hi) { unsigned r; asm volatile("v_cvt_pk_bf16_f32 %0, %1, %2" : "=v"(r) : "v"(lo), "v"(hi)); return r; }
typedef float f32x2 __attribute__((ext_vector_type(2)));
template <class Epi, class Sched, bool ALIGN_EPI = false, bool SP2 = false>
__device__ __forceinline__ void gemm_phase(PG8_LAS unsigned char* lds, const Gemm g, const Sched& S, const Epi& E) {
    int tid_ = threadIdx.x; asm volatile("" : "+v"(tid_));
    const int tid = tid_, wid = __builtin_amdgcn_readfirstlane(tid >> 6), lane = tid & 63, wr = wid >> 2, wc = wid & 3, fr = lane & 15, fq = lane >> 4;
    const int K = g.K, nt = K / BK;
    unsigned voffA[2], voffB[2];
#pragma unroll
    for (int i = 0; i < 2; ++i) { int R, C; stage_rc(tid * 16 + i * 8192, R, C); const int Rb = Epi::PERM ? ((R & ~31) + perm32(R & 31)) : R;
        voffA[i] = (unsigned)(R * K + C) * 2u; voffB[i] = (unsigned)(Rb * K + C) * 2u; }
    const size_t kstep = (size_t)(BK * 2);
    const size_t hstep = (size_t)HALF * K * 2;
    const size_t tstep = 2 * hstep;
    const unsigned ldsw = (unsigned)wid * 1024u;
    const int aoff = lds_byte(wr * 64 + fr, fq * 8), boff = lds_byte(wc * 32 + fr, fq * 8);
#define PG8_SA(b, h) (((b) * 2 + (h)) * HTB)
#define PG8_SB(b, h) ((4 + (b) * 2 + (h)) * HTB)
#define PG8_STAGE(bufoff, gbase, voff) do { _Pragma("unroll") for (int _i = 0; _i < 2; ++_i) \
        __builtin_amdgcn_global_load_lds((const unsigned*)((const char*)(gbase) + (voff)[_i]), (PG8_LAS unsigned*)(lds + (bufoff) + ldsw + _i * 8192), 16, 0, 0); } while (0)
#define PG8_LDA(dst, b, h) do { _Pragma("unroll") for (int m = 0; m < 4; ++m) _Pragma("unroll") for (int k = 0; k < 2; ++k) dst[m][k] = *(const PG8_LAS bf16x8*)(lds + PG8_SA(b, h) + aoff + m * 2048 + k * 1024); } while (0)
#define PG8_LDB(dst, b, h) do { _Pragma("unroll") for (int n = 0; n < 2; ++n) _Pragma("unroll") for (int k = 0; k < 2; ++k) dst[n][k] = *(const PG8_LAS bf16x8*)(lds + PG8_SB(b, h) + boff + n * 2048 + k * 1024); } while (0)
#define PG8_MMA(ai, bj, At, Bt) do { __builtin_amdgcn_s_setprio(1); _Pragma("unroll") for (int m = 0; m < 4; ++m) _Pragma("unroll") for (int n = 0; n < 2; ++n) _Pragma("unroll") for (int k = 0; k < 2; ++k) \
        acc[ai][bj][m][n] = __builtin_amdgcn_mfma_f32_16x16x32_bf16(Bt[n][k], At[m][k], acc[ai][bj][m][n], 0, 0, 0); __builtin_amdgcn_s_setprio(0); } while (0)
#define PG8_WAIT_V(n) asm volatile("s_waitcnt vmcnt(" #n ")" ::: "memory")
#define PG8_WAIT_L(n) asm volatile("s_waitcnt lgkmcnt(" #n ")" ::: "memory")
#define PG8_BAR __builtin_amdgcn_s_barrier()
#define PG8_SCHED __builtin_amdgcn_sched_barrier(0)
    Unit cur, nxt; int ui = 0;
    if (!S.next(0, cur)) return;
    f32x4 acc[2][2][4][2];
#pragma unroll
    for (int a = 0; a < 2; ++a)
#pragma unroll
        for (int b = 0; b < 2; ++b)
#pragma unroll
            for (int m = 0; m < 4; ++m)
#pragma unroll
                for (int n = 0; n < 2; ++n) acc[a][b][m][n] = (f32x4){0.f, 0.f, 0.f, 0.f};
    bf16x8 At[4][2], B0[2][2], B1[2][2];
    const char* cA = (const char*)g.A + (size_t)cur.pm * tstep; const char* cB = (const char*)g.Bt + (size_t)cur.pn * tstep;
    S.a_ready(cur);
    if constexpr (SP2) {
        PG8_STAGE(PG8_SB(0, 0), cB, voffB); PG8_STAGE(PG8_SB(0, 1), cB + hstep, voffB); PG8_STAGE(PG8_SA(0, 0), cA, voffA); PG8_STAGE(PG8_SA(0, 1), cA + hstep, voffA);
        if (wr == 1) PG8_BAR;
        PG8_WAIT_V(2); PG8_BAR;
        PG8_STAGE(PG8_SB(1, 0), cB + kstep, voffB); PG8_STAGE(PG8_SA(1, 0), cA + kstep, voffA); PG8_STAGE(PG8_SB(1, 1), cB + hstep + kstep, voffB);
        PG8_WAIT_V(6); PG8_BAR;
    } else {
        PG8_STAGE(PG8_SB(0, 0), cB, voffB); PG8_STAGE(PG8_SA(0, 0), cA, voffA); PG8_STAGE(PG8_SB(0, 1), cB + hstep, voffB); PG8_STAGE(PG8_SA(0, 1), cA + hstep, voffA);
        if (wr == 1) PG8_BAR;
        PG8_WAIT_V(4); PG8_BAR;
        PG8_STAGE(PG8_SB(1, 0), cB + kstep, voffB); PG8_STAGE(PG8_SA(1, 0), cA + kstep, voffA); PG8_STAGE(PG8_SB(1, 1), cB + hstep + kstep, voffB);
        PG8_WAIT_V(6); PG8_BAR;
    }
    for (;;) {
        const bool has_next = S.next(ui + 1, nxt);
        const char* nA = has_next ? (const char*)g.A + (size_t)nxt.pm * tstep : cA; const char* nB = has_next ? (const char*)g.Bt + (size_t)nxt.pn * tstep : cB;
        for (int t = 0; t < nt; t += 2) {
            const bool last = (t == nt - 2);
            const char* a1 = cA + (size_t)(t + 1) * kstep;
            const char* a2 = last ? nA : cA + (size_t)(t + 2) * kstep; const char* b2 = last ? nB : cB + (size_t)(t + 2) * kstep;
            const char* a3 = a2 + kstep; const char* b3 = b2 + kstep;
            if (last && has_next) S.a_ready(nxt);
            if constexpr (SP2) {
            PG8_LDB(B0, 0, 0); PG8_LDB(B1, 0, 1); PG8_SCHED; PG8_LDA(At, 0, 0); PG8_STAGE(PG8_SA(1, 1), a1 + hstep, voffA);
            PG8_WAIT_V(8); PG8_WAIT_L(0); PG8_BAR; PG8_MMA(0, 0, At, B0); PG8_MMA(0, 1, At, B1); PG8_BAR; PG8_SCHED;
            PG8_LDA(At, 0, 1); PG8_STAGE(PG8_SB(0, 0), b2, voffB); PG8_STAGE(PG8_SB(0, 1), b2 + hstep, voffB); PG8_STAGE(PG8_SA(0, 0), a2, voffA);
            PG8_WAIT_V(8); PG8_WAIT_L(0); PG8_BAR; PG8_MMA(1, 0, At, B0); PG8_MMA(1, 1, At, B1); PG8_BAR; PG8_SCHED;
            PG8_LDB(B0, 1, 0); PG8_LDB(B1, 1, 1); PG8_SCHED; PG8_LDA(At, 1, 0); PG8_STAGE(PG8_SA(0, 1), a2 + hstep, voffA);
            PG8_WAIT_V(8); PG8_WAIT_L(0); PG8_BAR; PG8_MMA(0, 0, At, B0); PG8_MMA(0, 1, At, B1); PG8_BAR; PG8_SCHED;
            PG8_LDA(At, 1, 1); PG8_STAGE(PG8_SB(1, 0), b3, voffB); PG8_STAGE(PG8_SB(1, 1), b3 + hstep, voffB); PG8_STAGE(PG8_SA(1, 0), a3, voffA);
            PG8_WAIT_V(8); PG8_WAIT_L(0); PG8_BAR; PG8_MMA(1, 0, At, B0); PG8_MMA(1, 1, At, B1); PG8_BAR; PG8_SCHED;
            } else {
            PG8_LDB(B0, 0, 0); PG8_SCHED; PG8_LDA(At, 0, 0); PG8_STAGE(PG8_SA(1, 1), a1 + hstep, voffA);
            PG8_WAIT_L(8); PG8_BAR; PG8_WAIT_L(0); PG8_MMA(0, 0, At, B0); PG8_BAR; PG8_SCHED;
            PG8_LDB(B1, 0, 1); PG8_STAGE(PG8_SB(0, 0), b2, voffB);
            PG8_BAR; PG8_WAIT_L(0); PG8_MMA(0, 1, At, B1); PG8_BAR;
            PG8_LDA(At, 0, 1); PG8_STAGE(PG8_SA(0, 0), a2, voffA);
            PG8_BAR; PG8_WAIT_L(0); PG8_MMA(1, 0, At, B0); PG8_BAR; PG8_SCHED;
            PG8_STAGE(PG8_SB(0, 1), b2 + hstep, voffB);
            PG8_WAIT_V(6); PG8_BAR; PG8_MMA(1, 1, At, B1); PG8_BAR;
            PG8_LDB(B0, 1, 0); PG8_SCHED; PG8_LDA(At, 1, 0); PG8_STAGE(PG8_SA(0, 1), a2 + hstep, voffA);
            PG8_WAIT_L(8); PG8_BAR; PG8_WAIT_L(0); PG8_MMA(0, 0, At, B0); PG8_BAR; PG8_SCHED;
            PG8_LDB(B1, 1, 1); PG8_STAGE(PG8_SB(1, 0), b3, voffB);
            PG8_BAR; PG8_WAIT_L(0); PG8_MMA(0, 1, At, B1); PG8_BAR;
            PG8_LDA(At, 1, 1); PG8_STAGE(PG8_SA(1, 0), a3, voffA);
            PG8_BAR; PG8_WAIT_L(0); PG8_MMA(1, 0, At, B0); PG8_BAR; PG8_SCHED;
            PG8_STAGE(PG8_SB(1, 1), b3 + hstep, voffB);
            PG8_WAIT_V(6); PG8_BAR; PG8_MMA(1, 1, At, B1); PG8_BAR;
            }
        }
        if constexpr (ALIGN_EPI) { if (wr == 0) PG8_BAR; }
        if constexpr (!Epi::AFTER_DRAIN) { E(acc, cur, wr, wc, fr, fq); S.done(cur); }
        if (!has_next) break;
#pragma unroll
        for (int a = 0; a < 2; ++a)
#pragma unroll
            for (int b = 0; b < 2; ++b)
#pragma unroll
                for (int m = 0; m < 4; ++m)
#pragma unroll
                    for (int n = 0; n < 2; ++n) acc[a][b][m][n] = (f32x4){0.f, 0.f, 0.f, 0.f};
        cur = nxt; cA = nA; cB = nB; ++ui;
        if constexpr (ALIGN_EPI) { if (wr == 1) PG8_BAR; }
    }
    PG8_WAIT_V(0);
    if constexpr (!ALIGN_EPI) { if (wr == 0) PG8_BAR; }
    PG8_BAR;
    if constexpr (Epi::AFTER_DRAIN) { E.fused(acc, cur, wr, wc, fr, fq, lds, wid, lane); S.done(cur); }
#undef PG8_SA
#undef PG8_SB
#undef PG8_STAGE
#undef PG8_LDA
#undef PG8_LDB
#undef PG8_MMA
#undef PG8_WAIT_V
#undef PG8_WAIT_L
#undef PG8_BAR
#undef PG8_SCHED
}
}

constexpr int DM = 2048, SEQ = 4096, NB = 2, MROWS = NB * SEQ;
constexpr int AW = 4096, NG = 8, GD = 512, CH = 128;
constexpr int NH = 16, HD = 128;
constexpr float LN_EPS = 1e-5f;
constexpr float DN_ALPHA = 1.4142135623730951f;
constexpr float QSCALE = 0.08838834764831845f * 1.4426950408889634f;

#define LAS __attribute__((address_space(3)))
typedef unsigned short bf16;
typedef float f32x4 __attribute__((ext_vector_type(4)));
typedef float f32x2 __attribute__((ext_vector_type(2)));
typedef float f32x16 __attribute__((ext_vector_type(16)));
typedef short bf16x8 __attribute__((ext_vector_type(8)));
typedef short s16x4 __attribute__((ext_vector_type(4)));
typedef unsigned u32x4 __attribute__((ext_vector_type(4)));
typedef unsigned u32x2 __attribute__((ext_vector_type(2)));

__device__ __forceinline__ int opaque_tid() { int t = threadIdx.x; asm volatile("" : "+v"(t)); return t; }
__device__ __forceinline__ unsigned cvtpk(float lo, float hi) { unsigned r; asm volatile("v_cvt_pk_bf16_f32 %0, %1, %2" : "=v"(r) : "v"(lo), "v"(hi)); return r; }
__device__ __forceinline__ float bf2f(unsigned short b) { return __uint_as_float(((unsigned)b) << 16); }
__device__ __forceinline__ float gelu_tanh(float x) { const float t = x * (1.f + 0.044715f * x * x) * 2.302208198f; return x * __builtin_amdgcn_rcpf(1.f + __builtin_amdgcn_exp2f(-t)); }
__device__ __forceinline__ float silu_f(float x) { return x * __builtin_amdgcn_rcpf(1.f + __builtin_amdgcn_exp2f(-1.4426950408889634f * x)); }

namespace pg8 {
__device__ __forceinline__ f32x4 gelu4(f32x4 v) { return (f32x4){gelu_tanh(v[0]), gelu_tanh(v[1]), gelu_tanh(v[2]), gelu_tanh(v[3])}; }
__device__ __forceinline__ f32x4 silu4(f32x4 v) { return (f32x4){silu_f(v[0]), silu_f(v[1]), silu_f(v[2]), silu_f(v[3])}; }
struct EpiG1 {
    static constexpr bool PERM = true, AFTER_DRAIN = false;
    bf16_t* base; size_t rstride; float* stats; const float* bias;
    __device__ __forceinline__ void operator()(const f32x4 (&acc)[2][2][4][2], const Unit& u, int wr, int wc, int fr, int fq) const {
        const int region = u.pn >> 4, pnr = u.pn & 15;
        const int col0 = pnr * BM + wc * 32 + 8 * fq, bcol0 = u.pn * BM + wc * 32 + 8 * fq;
        f32x4 bv[2][2];
#pragma unroll
        for (int bj = 0; bj < 2; ++bj)
#pragma unroll
            for (int n = 0; n < 2; ++n) bv[bj][n] = *(const f32x4*)(bias + bcol0 + bj * HALF + 4 * n);
#pragma unroll
        for (int ai = 0; ai < 2; ++ai)
#pragma unroll
            for (int m = 0; m < 4; ++m) {
                const int row = u.pm * BM + ai * HALF + wr * 64 + m * 16 + fr;
                float s = 0.f, ss = 0.f;
#pragma unroll
                for (int bj = 0; bj < 2; ++bj) {
                    f32x4 a0 = acc[ai][bj][m][0] + bv[bj][0], a1 = acc[ai][bj][m][1] + bv[bj][1];
                    if (region == 2) { a0 = silu4(a0); a1 = silu4(a1); } else { a0 = gelu4(a0); a1 = gelu4(a1); }
                    u32x4 w; w.x = cvtpk(a0[0], a0[1]); w.y = cvtpk(a0[2], a0[3]); w.z = cvtpk(a1[0], a1[1]); w.w = cvtpk(a1[2], a1[3]);
                    if (region == 1) {
                        s += ((a0[0] + a0[1]) + (a0[2] + a0[3])) + ((a1[0] + a1[1]) + (a1[2] + a1[3]));
                        ss += ((a0[0] * a0[0] + a0[1] * a0[1]) + (a0[2] * a0[2] + a0[3] * a0[3])) + ((a1[0] * a1[0] + a1[1] * a1[1]) + (a1[2] * a1[2] + a1[3] * a1[3]));
                        bf16_t* tp = base + rstride + ((size_t)(row >> 7) * AW + col0 + bj * HALF) * CH + (row & 127);
                        tp[0 * CH] = (bf16_t)(w.x & 0xffffu); tp[1 * CH] = (bf16_t)(w.x >> 16); tp[2 * CH] = (bf16_t)(w.y & 0xffffu); tp[3 * CH] = (bf16_t)(w.y >> 16);
                        tp[4 * CH] = (bf16_t)(w.z & 0xffffu); tp[5 * CH] = (bf16_t)(w.z >> 16); tp[6 * CH] = (bf16_t)(w.w & 0xffffu); tp[7 * CH] = (bf16_t)(w.w >> 16);
                    } else {
                        bf16_t* dst = base + (size_t)region * rstride + (size_t)row * AW + col0 + bj * HALF;
                        *(u32x4*)dst = w;
                    }
                }
                if (region == 1) {
                    s += __shfl_xor(s, 16); s += __shfl_xor(s, 32); ss += __shfl_xor(ss, 16); ss += __shfl_xor(ss, 32);
                    if (fq == 0) *(f32x2*)(stats + ((size_t)row * 64 + pnr * 4 + wc) * 2) = (f32x2){s, ss};
                }
            }
    }
};
struct EpiG3 {
    static constexpr bool PERM = true, AFTER_DRAIN = false;
    bf16_t* base; size_t rstride;
    __device__ __forceinline__ void operator()(const f32x4 (&acc)[2][2][4][2], const Unit& u, int wr, int wc, int fr, int fq) const {
        const int region = u.pn >> 3, pnr = u.pn & 7;
        const int col0 = pnr * BM + wc * 32 + 8 * fq;
#pragma unroll
        for (int ai = 0; ai < 2; ++ai)
#pragma unroll
            for (int m = 0; m < 4; ++m) {
                const int row = u.pm * BM + ai * HALF + wr * 64 + m * 16 + fr;
#pragma unroll
                for (int bj = 0; bj < 2; ++bj) {
                    f32x4 a0 = acc[ai][bj][m][0], a1 = acc[ai][bj][m][1];
                    if (region == 3) { a0 = silu4(a0); a1 = silu4(a1); } else if (region == 2) { a0 = a0 * QSCALE; a1 = a1 * QSCALE; }
                    u32x4 w; w.x = cvtpk(a0[0], a0[1]); w.y = cvtpk(a0[2], a0[3]); w.z = cvtpk(a1[0], a1[1]); w.w = cvtpk(a1[2], a1[3]);
                    if (region == 1) {
                        bf16_t* tp = base + rstride + ((size_t)(row >> 12) * DM + col0 + bj * HALF) * SEQ + (row & (SEQ - 1));
                        tp[0 * SEQ] = (bf16_t)(w.x & 0xffffu); tp[1 * SEQ] = (bf16_t)(w.x >> 16); tp[2 * SEQ] = (bf16_t)(w.y & 0xffffu); tp[3 * SEQ] = (bf16_t)(w.y >> 16);
                        tp[4 * SEQ] = (bf16_t)(w.z & 0xffffu); tp[5 * SEQ] = (bf16_t)(w.z >> 16); tp[6 * SEQ] = (bf16_t)(w.w & 0xffffu); tp[7 * SEQ] = (bf16_t)(w.w >> 16);
                    } else {
                        bf16_t* dst = base + (size_t)region * rstride + (size_t)row * DM + col0 + bj * HALF;
                        *(u32x4*)dst = w;
                    }
                }
            }
    }
};
struct EpiRes {
    static constexpr bool PERM = false, AFTER_DRAIN = false;
    const float* X; float* Z;
    __device__ __forceinline__ void operator()(const f32x4 (&acc)[2][2][4][2], const Unit& u, int wr, int wc, int fr, int fq) const {
        const int col0 = u.pn * BM + wc * 32 + 4 * fq;
#pragma unroll
        for (int ai = 0; ai < 2; ++ai)
#pragma unroll
            for (int m = 0; m < 4; ++m) {
                const size_t off = (size_t)(u.pm * BM + ai * HALF + wr * 64 + m * 16 + fr) * DM + col0;
#pragma unroll
                for (int bj = 0; bj < 2; ++bj)
#pragma unroll
                    for (int n = 0; n < 2; ++n) { const f32x4 xv = *(const f32x4*)(X + off + bj * HALF + n * 16); *(f32x4*)(Z + off + bj * HALF + n * 16) = xv * DN_ALPHA + acc[ai][bj][m][n]; }
            }
    }
};
}

constexpr size_t MiB = 1u << 20;
constexpr size_t WS_W2T = 0 * MiB;
constexpr size_t WS_W3T = 16 * MiB;
constexpr size_t WS_W4T = 48 * MiB;
constexpr size_t WS_W1T = 56 * MiB;
constexpr size_t WS_XB  = 104 * MiB;
constexpr size_t WS_SM  = 56 * MiB;
constexpr size_t WS_U   = 136 * MiB;
constexpr size_t WS_GVT = 200 * MiB;
constexpr size_t WS_SG  = 264 * MiB;
constexpr size_t WS_ST  = 328 * MiB;
constexpr size_t WS_Z   = 136 * MiB;
constexpr size_t WS_X1  = 200 * MiB;
constexpr size_t WS_X1B = 264 * MiB;
constexpr size_t WS_KB  = 56 * MiB;
constexpr size_t WS_VT  = 88 * MiB;
constexpr size_t WS_QB  = 120 * MiB;
constexpr size_t WS_SGB = 152 * MiB;
constexpr size_t WS_OG  = 296 * MiB;
constexpr size_t WS_Z2  = 56 * MiB;
constexpr size_t WS_END = 332 * MiB;
static_assert(WS_SG - WS_GVT == WS_GVT - WS_U && WS_VT - WS_KB == WS_QB - WS_VT && WS_SGB - WS_QB == WS_VT - WS_KB, "region strides");

constexpr int LDS_BYTES = 147456;
constexpr int NWAVES = 8;

struct Params {
    const float* x; const float* a_w_in; const float* a_b_in; const float* a_vln_g; const float* a_vln_b; const float* a_w_s; const float* a_b_s; const float* a_w_out;
    const float* kv_w; const float* b_w_in; const float* b_w_out; const float* ln_g; const float* ln_b;
    float* out; unsigned char* ws;
};

__device__ __forceinline__ void p0_transpose_item(const float* W, int K, int N, bf16* WT, int row_off, LAS float* scr, int item, int lane) {
    const int nblk = N / 64, kb = item / nblk, nb = item % nblk, k0 = 64 * kb, n0 = 64 * nb;
    const int lr = lane >> 4, lc = (lane & 15) * 4;
    f32x4 v[16];
#pragma unroll
    for (int i = 0; i < 16; ++i) v[i] = __builtin_nontemporal_load((const f32x4*)(W + (size_t)(k0 + 4 * i + lr) * N + n0 + lc));
#pragma unroll
    for (int i = 0; i < 16; ++i) { LAS float* d = scr + (4 * i + lr) * 65 + lc; d[0] = v[i][0]; d[1] = v[i][1]; d[2] = v[i][2]; d[3] = v[i][3]; }
    asm volatile("s_waitcnt lgkmcnt(0)" ::: "memory");
    const int c = lane & 7;
#pragma unroll
    for (int j = 0; j < 8; ++j) { const int n = (lane >> 3) + 8 * j; const LAS float* s = scr + (8 * c) * 65 + n;
        u32x4 o; o.x = cvtpk(s[0 * 65], s[1 * 65]); o.y = cvtpk(s[2 * 65], s[3 * 65]); o.z = cvtpk(s[4 * 65], s[5 * 65]); o.w = cvtpk(s[6 * 65], s[7 * 65]);
        *(u32x4*)(WT + (size_t)(row_off + n0 + n) * K + k0 + 8 * c) = o; }
    asm volatile("s_waitcnt lgkmcnt(0)" ::: "memory");
}
__device__ __forceinline__ void p0_phase(LAS unsigned char* lds, const Params& p, int G) {
    const int tid = opaque_tid(), lane = tid & 63, wave = tid >> 6;
    LAS float* scr = (LAS float*)(lds + wave * 16640);
    const int gw = blockIdx.x * NWAVES + wave, NGW = G * NWAVES;
    constexpr int I_1 = (DM / 64) * (3 * AW / 64), I_2 = (AW / 64) * (DM / 64), I_KV = (DM / 64) * (2 * DM / 64), I_BI = I_KV, I_BO = (DM / 64) * (DM / 64);
    constexpr int NITEMS = I_1 + I_2 + I_KV + I_BI + I_BO;
    bf16* W1T = (bf16*)(p.ws + WS_W1T); bf16* W2T = (bf16*)(p.ws + WS_W2T); bf16* W3T = (bf16*)(p.ws + WS_W3T); bf16* W4T = (bf16*)(p.ws + WS_W4T);
    for (int it = gw; it < NITEMS; it += NGW) {
        int r = it;
        if (r < I_1) { p0_transpose_item(p.a_w_in, DM, 3 * AW, W1T, 0, scr, r, lane); continue; } r -= I_1;
        if (r < I_2) { p0_transpose_item(p.a_w_out, AW, DM, W2T, 0, scr, r, lane); continue; } r -= I_2;
        if (r < I_KV) { p0_transpose_item(p.kv_w, DM, 2 * DM, W3T, 0, scr, r, lane); continue; } r -= I_KV;
        if (r < I_BI) { p0_transpose_item(p.b_w_in, DM, 2 * DM, W3T, 2 * DM, scr, r, lane); continue; } r -= I_BI;
        p0_transpose_item(p.b_w_out, DM, DM, W4T, 0, scr, r, lane);
    }
    bf16* XB = (bf16*)(p.ws + WS_XB);
    const size_t n8 = (size_t)MROWS * DM / 8, step = (size_t)G * 512;
    for (size_t i0 = (size_t)blockIdx.x * 512 + tid; i0 < n8; i0 += 4 * step) {
        f32x4 a[4], b[4];
#pragma unroll
        for (int k = 0; k < 4; ++k) { const size_t i = i0 + k * step; if (i < n8) { a[k] = __builtin_nontemporal_load((const f32x4*)(p.x + i * 8)); b[k] = __builtin_nontemporal_load((const f32x4*)(p.x + i * 8 + 4)); } }
#pragma unroll
        for (int k = 0; k < 4; ++k) { const size_t i = i0 + k * step; if (i < n8) {
            u32x4 o; o.x = cvtpk(a[k][0], a[k][1]); o.y = cvtpk(a[k][2], a[k][3]); o.z = cvtpk(b[k][0], b[k][1]); o.w = cvtpk(b[k][2], b[k][3]);
            *(u32x4*)(XB + i * 8) = o; } }
    }
}

__device__ __forceinline__ void mix_phase(LAS unsigned char* lds, const Params& p, int job_lo, int job_step) {
    constexpr int TP = 272;
    constexpr int OFF_A = 0, OFF_B = 128 * TP, OFF_MU = 2 * 128 * TP, OFF_RS = OFF_MU + 512, OFF_C1 = OFF_RS + 512, OFF_C2 = OFF_C1 + 512;
    const int tid = opaque_tid(), lane = tid & 63, wid = tid >> 6, wr = wid >> 2, wc = wid & 3, fr = lane & 15, fq = lane >> 4;
    const bf16* U = (const bf16*)(p.ws + WS_U); const bf16* GVt = (const bf16*)(p.ws + WS_GVT); const bf16* SG = (const bf16*)(p.ws + WS_SG);
    const float* stats = (const float*)(p.ws + WS_ST); bf16* SM = (bf16*)(p.ws + WS_SM);
    LAS float* mu = (LAS float*)(lds + OFF_MU); LAS float* rs = (LAS float*)(lds + OFF_RS); LAS float* c1s = (LAS float*)(lds + OFF_C1); LAS float* c2s = (LAS float*)(lds + OFF_C2);
    for (int job = job_lo; job < 256; job += job_step) {
        const int chunk = job >> 2, part = job & 3;
        __syncthreads();
        {
            const int row = tid >> 2, q = tid & 3;
            const f32x2* sp = (const f32x2*)stats + ((size_t)(chunk * CH + row) * 64 + q * 16);
            float s = 0.f, ss = 0.f;
#pragma unroll
            for (int i = 0; i < 16; ++i) { const f32x2 v = sp[i]; s += v.x; ss += v.y; }
            s += __shfl_xor(s, 1); s += __shfl_xor(s, 2); ss += __shfl_xor(ss, 1); ss += __shfl_xor(ss, 2);
            const float mean = s * (1.f / AW), var = ss * (1.f / AW) - mean * mean;
            if (q == 0) { mu[row] = mean; rs[row] = 1.0f / sqrtf(var + LN_EPS); }
        }
        __syncthreads();
        for (int gi = 0; gi < 2; ++gi) {
            const int g = part * 2 + gi;
            __syncthreads();
            {
                const int t = tid >> 2, q = tid & 3;
                const float* wrow = p.a_w_s + ((size_t)g * CH + t) * CH + q * 32;
                float c1 = 0.f, c2 = 0.f;
#pragma unroll
                for (int i = 0; i < 4; ++i) {
                    const f32x4 w0 = *(const f32x4*)(wrow + i * 8), w1 = *(const f32x4*)(wrow + i * 8 + 4);
                    float w[8] = {w0[0], w0[1], w0[2], w0[3], w1[0], w1[1], w1[2], w1[3]};
                    float wp[8];
#pragma unroll
                    for (int j = 0; j < 8; ++j) { const int s = q * 32 + i * 8 + j; const float wm = (s <= t) ? w[j] : 0.f; c2 += wm; wp[j] = wm * rs[s]; }
                    u32x4 o; o.x = cvtpk(wp[0], wp[1]); o.y = cvtpk(wp[2], wp[3]); o.z = cvtpk(wp[4], wp[5]); o.w = cvtpk(wp[6], wp[7]);
#pragma unroll
                    for (int j = 0; j < 4; ++j) { const unsigned pk = o[j]; const int s = q * 32 + i * 8 + 2 * j; c1 += __uint_as_float(pk << 16) * mu[s] + __uint_as_float(pk & 0xffff0000u) * mu[s + 1]; }
                    *(LAS u32x4*)(lds + OFF_A + t * TP + (q * 32 + i * 8) * 2) = o;
                }
                c1 += __shfl_xor(c1, 1); c1 += __shfl_xor(c1, 2); c2 += __shfl_xor(c2, 1); c2 += __shfl_xor(c2, 2);
                if (q == 0) { c1s[t] = c1; c2s[t] = c2; }
            }
            for (int eb = 0; eb < 4; ++eb) {
                const int ecol0 = g * GD + eb * 128;
                __syncthreads();
                {
                    const int er = tid >> 2, pc = tid & 3;
                    const bf16* src = GVt + ((size_t)chunk * AW + ecol0 + er) * CH + pc * 32;
                    const u32x4 b0 = *(const u32x4*)(src), b1 = *(const u32x4*)(src + 8), b2 = *(const u32x4*)(src + 16), b3 = *(const u32x4*)(src + 24);
                    LAS unsigned char* d = lds + OFF_B + er * TP + pc * 64;
                    *(LAS u32x4*)(d) = b0; *(LAS u32x4*)(d + 16) = b1; *(LAS u32x4*)(d + 32) = b2; *(LAS u32x4*)(d + 48) = b3;
                }
                __syncthreads();
                f32x4 acc[4][2];
#pragma unroll
                for (int m = 0; m < 4; ++m)
#pragma unroll
                    for (int n = 0; n < 2; ++n) acc[m][n] = (f32x4){0.f, 0.f, 0.f, 0.f};
#pragma unroll
                for (int k = 0; k < 4; ++k) {
                    bf16x8 af[4], bfr[2];
#pragma unroll
                    for (int m = 0; m < 4; ++m) af[m] = *(const LAS bf16x8*)(lds + OFF_A + (wr * 64 + m * 16 + fr) * TP + (k * 32 + fq * 8) * 2);
#pragma unroll
                    for (int n = 0; n < 2; ++n) { const int erow = wc * 32 + 8 * (fr >> 2) + 4 * n + (fr & 3); bfr[n] = *(const LAS bf16x8*)(lds + OFF_B + erow * TP + (k * 32 + fq * 8) * 2); }
#pragma unroll
                    for (int m = 0; m < 4; ++m)
#pragma unroll
                        for (int n = 0; n < 2; ++n) acc[m][n] = __builtin_amdgcn_mfma_f32_16x16x32_bf16(bfr[n], af[m], acc[m][n], 0, 0, 0);
                }
                const int ec = ecol0 + wc * 32 + 8 * fq;
                const f32x4 g0 = *(const f32x4*)(p.a_vln_g + ec), g1 = *(const f32x4*)(p.a_vln_g + ec + 4), be0 = *(const f32x4*)(p.a_vln_b + ec), be1 = *(const f32x4*)(p.a_vln_b + ec + 4);
#pragma unroll
                for (int m = 0; m < 4; ++m) {
                    const int t = wr * 64 + m * 16 + fr; const size_t off = (size_t)(chunk * CH + t) * AW + ec;
                    const float c1 = c1s[t], c2 = c2s[t], bs = p.a_b_s[g * CH + t];
                    const u32x4 uu = *(const u32x4*)(U + off), sg = *(const u32x4*)(SG + off);
                    const f32x4 m0 = g0 * (acc[m][0] - c1) + be0 * c2 + bs, m1 = g1 * (acc[m][1] - c1) + be1 * c2 + bs;
                    float r[8];
#pragma unroll
                    for (int j = 0; j < 4; ++j) {
                        const float mlo = (j < 2) ? m0[2 * j] : m1[2 * j - 4], mhi = (j < 2) ? m0[2 * j + 1] : m1[2 * j - 3];
                        r[2 * j] = __uint_as_float(uu[j] << 16) * mlo * __uint_as_float(sg[j] << 16);
                        r[2 * j + 1] = __uint_as_float(uu[j] & 0xffff0000u) * mhi * __uint_as_float(sg[j] & 0xffff0000u);
                    }
                    u32x4 o; o.x = cvtpk(r[0], r[1]); o.y = cvtpk(r[2], r[3]); o.z = cvtpk(r[4], r[5]); o.w = cvtpk(r[6], r[7]);
                    *(u32x4*)(SM + off) = o;
                }
            }
        }
    }
}

__device__ __forceinline__ void ln_phase(const float* Z, const float* gam, const float* bet, float* Xout, bf16* Xb, int G) {
    const int tid = opaque_tid(), lane = tid & 63, wave = tid >> 6;
    f32x4 gv[8], bv[8];
#pragma unroll
    for (int j = 0; j < 8; ++j) { gv[j] = *(const f32x4*)(gam + (64 * j + lane) * 4); bv[j] = *(const f32x4*)(bet + (64 * j + lane) * 4); }
    for (int row = blockIdx.x * NWAVES + wave; row < MROWS; row += G * NWAVES) {
        const f32x4* zr = (const f32x4*)(Z + (size_t)row * DM) + lane;
        f32x4 v[8]; float s = 0.f;
#pragma unroll
        for (int j = 0; j < 8; ++j) { v[j] = zr[64 * j]; s += (v[j][0] + v[j][1]) + (v[j][2] + v[j][3]); }
#pragma unroll
        for (int o = 1; o < 64; o <<= 1) s += __shfl_xor(s, o);
        const float mean = s * (1.f / DM); float s2 = 0.f;
#pragma unroll
        for (int j = 0; j < 8; ++j) { v[j] = v[j] - mean; s2 += (v[j][0] * v[j][0] + v[j][1] * v[j][1]) + (v[j][2] * v[j][2] + v[j][3] * v[j][3]); }
#pragma unroll
        for (int o = 1; o < 64; o <<= 1) s2 += __shfl_xor(s2, o);
        const float rstd = 1.0f / sqrtf(s2 * (1.f / DM) + LN_EPS);
#pragma unroll
        for (int j = 0; j < 8; ++j) {
            const f32x4 y = v[j] * rstd * gv[j] + bv[j];
            *((f32x4*)(Xout + (size_t)row * DM) + 64 * j + lane) = y;
            if (Xb) { u32x2 w; w.x = cvtpk(y[0], y[1]); w.y = cvtpk(y[2], y[3]); *((u32x2*)(Xb + (size_t)row * DM) + 64 * j + lane) = w; }
        }
    }
}

namespace sba {
constexpr int KP = 272, VP = 136;
constexpr int KSB = 64 * KP, VSB = 128 * VP;
constexpr int OFF_K = 0, OFF_V = 2 * KSB, OFF_FLAG = 2 * KSB + 2 * VSB;
#ifndef SBA_EARLY_EXIT
#define SBA_EARLY_EXIT 1
#endif
__device__ __forceinline__ int crow(int r, int hi) { return (r & 3) + 8 * (r >> 2) + 4 * hi; }
__device__ __forceinline__ void sb_block(f32x16& p, float& c, int kbase, int trow, int hi, bool band) {
    float sfx[16];
#pragma unroll
    for (int r = 0; r < 16; ++r) {
        float e = __builtin_amdgcn_exp2f(__builtin_fminf(p[r], 100.f));
        if (band) { const int key = kbase + crow(r, hi); e = (key < trow) ? e : 0.f; }
        p[r] = e; sfx[r] = 1.f + e;
    }
    float lo[4], hh[4];
#pragma unroll
    for (int k = 0; k < 4; ++k) {
        sfx[4 * k + 2] *= sfx[4 * k + 3]; sfx[4 * k + 1] *= sfx[4 * k + 2]; sfx[4 * k] *= sfx[4 * k + 1];
        const unsigned tb = __float_as_uint(sfx[4 * k]);
        auto rr = __builtin_amdgcn_permlane32_swap(tb, tb, false, false);
        lo[k] = __uint_as_float(rr[0]); hh[k] = __uint_as_float(rr[1]);
    }
    float E[4];
#pragma unroll
    for (int k = 3; k >= 0; --k) { const float eh = c; c *= hh[k]; const float el = c; c *= lo[k]; E[k] = hi ? eh : el; }
#pragma unroll
    for (int r = 0; r < 16; ++r) p[r] = p[r] * __builtin_amdgcn_rcpf(sfx[r] * E[r >> 2]);
}
__device__ __forceinline__ void attn_unit(LAS unsigned char* lds, int b, int h, int qb, const bf16* Qb, const bf16* Kb, const bf16* Vt, const bf16* SGb, bf16* OG) {
    const int tid = opaque_tid(), lane = tid & 63, r32 = lane & 31, hi = lane >> 5;
    const int wid = __builtin_amdgcn_readfirstlane(tid >> 6);
    const int t0 = qb * 256, tw0 = t0 + wid * 32, trow = tw0 + r32;
    const size_t rowbase = (size_t)b * SEQ;
    bf16x8 qr[8];
    { const bf16* qp = Qb + (rowbase + trow) * DM + h * HD + hi * 8;
#pragma unroll
      for (int d0 = 0; d0 < 8; ++d0) qr[d0] = *(const bf16x8*)(qp + d0 * 16); }
    f32x16 o[4];
#pragma unroll
    for (int i = 0; i < 4; ++i)
#pragma unroll
        for (int r = 0; r < 16; ++r) o[i][r] = 0.f;
    float R = 1.f;
    const int krow = tid >> 3, kpc = tid & 7, vrow = tid >> 2, vpc = tid & 3;
    const bf16* kg = Kb + (rowbase + krow) * DM + h * HD + kpc * 16;
    const bf16* vg = Vt + ((size_t)(b * NH + h) * HD + vrow) * SEQ + vpc * 16;
    LAS unsigned char* kdst = lds + OFF_K + krow * KP + kpc * 32;
    LAS unsigned char* vdst = lds + OFF_V + vrow * VP + vpc * 32;
    LAS unsigned* flags = (LAS unsigned*)(lds + OFF_FLAG);
    const int jmax = 4 * qb + 3;
    u32x4 kr0, kr1, vr0, vr1;
#define SBA_LOAD(j) do { const bf16* kp_ = kg + (size_t)(j) * 64 * DM; kr0 = *(const u32x4*)kp_; kr1 = *(const u32x4*)(kp_ + 8); const bf16* vp_ = vg + (j) * 64; vr0 = *(const u32x4*)vp_; vr1 = *(const u32x4*)(vp_ + 8); } while (0)
#define SBA_STORE(bf) do { LAS unsigned char* kd_ = kdst + (bf) * KSB; *(LAS u32x4*)kd_ = kr0; *(LAS u32x4*)(kd_ + 16) = kr1; LAS unsigned char* vd_ = vdst + (bf) * VSB; \
        *(LAS u32x2*)vd_ = (u32x2){vr0.x, vr0.y}; *(LAS u32x2*)(vd_ + 8) = (u32x2){vr0.z, vr0.w}; *(LAS u32x2*)(vd_ + 16) = (u32x2){vr1.x, vr1.y}; *(LAS u32x2*)(vd_ + 24) = (u32x2){vr1.z, vr1.w}; } while (0)
    SBA_LOAD(jmax); SBA_STORE(0);
    __syncthreads();
    bool wdone = false;
    for (int j = jmax, it = 0;; --j, ++it) {
        const int buf = it & 1;
        if (j > 0) SBA_LOAD(j - 1);
        const int k0 = 64 * j;
        if (k0 < tw0 + 32 && !wdone) {
            const LAS unsigned char* kb = lds + OFF_K + buf * KSB + r32 * KP + hi * 16;
            f32x16 p0, p1;
#pragma unroll
            for (int r = 0; r < 16; ++r) { p0[r] = 0.f; p1[r] = 0.f; }
#pragma unroll
            for (int d0 = 0; d0 < 8; ++d0) {
                const bf16x8 k0f = *(const LAS bf16x8*)(kb + d0 * 32), k1f = *(const LAS bf16x8*)(kb + 32 * KP + d0 * 32);
                p0 = __builtin_amdgcn_mfma_f32_32x32x16_bf16(k0f, qr[d0], p0, 0, 0, 0);
                p1 = __builtin_amdgcn_mfma_f32_32x32x16_bf16(k1f, qr[d0], p1, 0, 0, 0);
            }
            const bool band = (k0 + 63 >= tw0);
            sb_block(p1, R, k0 + 32, trow, hi, band);
            sb_block(p0, R, k0, trow, hi, band);
            bf16x8 pw[4];
            { u32x4 w;
              w.x = cvtpk(p0[0], p0[1]); w.y = cvtpk(p0[2], p0[3]); w.z = cvtpk(p0[4], p0[5]); w.w = cvtpk(p0[6], p0[7]); pw[0] = __builtin_bit_cast(bf16x8, w);
              w.x = cvtpk(p0[8], p0[9]); w.y = cvtpk(p0[10], p0[11]); w.z = cvtpk(p0[12], p0[13]); w.w = cvtpk(p0[14], p0[15]); pw[1] = __builtin_bit_cast(bf16x8, w);
              w.x = cvtpk(p1[0], p1[1]); w.y = cvtpk(p1[2], p1[3]); w.z = cvtpk(p1[4], p1[5]); w.w = cvtpk(p1[6], p1[7]); pw[2] = __builtin_bit_cast(bf16x8, w);
              w.x = cvtpk(p1[8], p1[9]); w.y = cvtpk(p1[10], p1[11]); w.z = cvtpk(p1[12], p1[13]); w.w = cvtpk(p1[14], p1[15]); pw[3] = __builtin_bit_cast(bf16x8, w); }
            const LAS unsigned char* vb = lds + OFF_V + buf * VSB + r32 * VP + hi * 8;
#pragma unroll
            for (int db = 0; db < 4; ++db)
#pragma unroll
                for (int ks = 0; ks < 4; ++ks) {
                    const s16x4 v0 = *(const LAS s16x4*)(vb + db * 32 * VP + ks * 32), v1 = *(const LAS s16x4*)(vb + db * 32 * VP + ks * 32 + 16);
                    const bf16x8 vf = (bf16x8){v0[0], v0[1], v0[2], v0[3], v1[0], v1[1], v1[2], v1[3]};
                    o[db] = __builtin_amdgcn_mfma_f32_32x32x16_bf16(pw[ks], vf, o[db], 0, 0, 0);
                }
#if SBA_EARLY_EXIT
            wdone = __all(R > 1e30f);
#endif
        }
        if (j > 0) SBA_STORE(buf ^ 1);
        if (lane == 0) flags[buf * 8 + wid] = wdone ? 1u : 0u;
        __syncthreads();
        if (j == 0) break;
        unsigned nd = 0;
#pragma unroll
        for (int w = 0; w < 8; ++w) nd += flags[buf * 8 + w];
        if (nd == 8u) break;
    }
#undef SBA_LOAD
#undef SBA_STORE
#pragma unroll
    for (int db = 0; db < 4; ++db)
#pragma unroll
        for (int r = 0; r < 16; ++r) {
            const size_t idx = (rowbase + tw0 + crow(r, hi)) * DM + h * HD + db * 32 + r32;
            const float v = o[db][r] * bf2f(SGb[idx]);
            OG[idx] = (bf16)(cvtpk(v, v) & 0xffffu);
        }
    __syncthreads();
}
}

#ifndef MK_PH_LO
#define MK_PH_LO 0
#endif
#ifndef MK_PH_HI
#define MK_PH_HI 9
#endif
__global__ void __launch_bounds__(NWAVES * 64, 2) yoco_fwd(Params p) {
    extern __shared__ __attribute__((aligned(16))) unsigned char lds_raw[];
    LAS unsigned char* lds = (LAS unsigned char*)lds_raw;
    cg::grid_group grid = cg::this_grid();
    const int G = gridDim.x, bx = blockIdx.x;
    const int vcu = (G % 8 == 0) ? (bx % 8) * (G / 8) + bx / 8 : bx;
    unsigned char* ws = p.ws;
    bf16* W1T = (bf16*)(ws + WS_W1T); bf16* W2T = (bf16*)(ws + WS_W2T); bf16* W3T = (bf16*)(ws + WS_W3T); bf16* W4T = (bf16*)(ws + WS_W4T);

#ifndef PHMASK
#define PHMASK 0x1ff
#endif
#ifndef REPMASK
#define REPMASK 0
#endif
#define NREP(k) (((REPMASK) >> (k)) & 1 ? 2 : 1)
#define PH(k) for (int rep_ = 0; rep_ < NREP(k); ++rep_) if ((rep_ ? (grid.sync(), true) : true) && ((PHMASK >> (k)) & 1))
    PH(0) p0_phase(lds, p, G);
    grid.sync();
    PH(1) {
        pg8::Gemm g{(const bf16*)(ws + WS_XB), W1T, MROWS, 3 * AW, DM}; pg8::StaticOrder S; S.init(MROWS, 3 * AW, G, bx);
        pg8::EpiG1 E{(bf16*)(ws + WS_U), (size_t)(WS_GVT - WS_U) / 2, (float*)(ws + WS_ST), p.a_b_in};
        pg8::gemm_phase<pg8::EpiG1, pg8::StaticOrder, true, true>(lds, g, S, E);
    }
    grid.sync();
    PH(2) mix_phase(lds, p, bx, G);
    grid.sync();
    PH(3) {
        pg8::Gemm g{(const bf16*)(ws + WS_SM), W2T, MROWS, DM, AW}; pg8::StaticOrder S; S.init(MROWS, DM, G, bx);
        pg8::EpiRes E{p.x, (float*)(ws + WS_Z)};
        pg8::gemm_phase<pg8::EpiRes, pg8::StaticOrder, true, true>(lds, g, S, E);
    }
    grid.sync();
    PH(4) ln_phase((const float*)(ws + WS_Z), p.ln_g, p.ln_b, (float*)(ws + WS_X1), (bf16*)(ws + WS_X1B), G);
    grid.sync();
    PH(5) {
        pg8::Gemm g{(const bf16*)(ws + WS_X1B), W3T, MROWS, 4 * DM, DM}; pg8::StaticOrder S; S.init(MROWS, 4 * DM, G, bx);
        pg8::EpiG3 E{(bf16*)(ws + WS_KB), (size_t)(WS_VT - WS_KB) / 2};
        pg8::gemm_phase<pg8::EpiG3, pg8::StaticOrder, true, true>(lds, g, S, E);
    }
    grid.sync();
    PH(6) {
        for (int v = vcu; v < 256; v += G) {
            const int bh = v >> 3, s = v & 7;
            for (int i = 0; i < 2; ++i)
                sba::attn_unit(lds, bh >> 4, bh & 15, i == 0 ? 15 - s : s, (const bf16*)(ws + WS_QB), (const bf16*)(ws + WS_KB), (const bf16*)(ws + WS_VT), (const bf16*)(ws + WS_SGB), (bf16*)(ws + WS_OG));
        }
    }
    grid.sync();
    PH(7) {
        pg8::Gemm g{(const bf16*)(ws + WS_OG), W4T, MROWS, DM, DM}; pg8::StaticOrder S; S.init(MROWS, DM, G, bx);
        pg8::EpiRes E{(const float*)(ws + WS_X1), (float*)(ws + WS_Z2)};
        pg8::gemm_phase<pg8::EpiRes, pg8::StaticOrder, true, true>(lds, g, S, E);
    }
    grid.sync();
    PH(8) ln_phase((const float*)(ws + WS_Z2), p.ln_g + DM, p.ln_b + DM, p.out, nullptr, G);
}

extern "C" void kernel_launch(void* const* d_in, const int* in_sizes, int n_in, void* d_out, int out_size, void* d_ws, size_t ws_size, hipStream_t stream) {
    static int grid = 0;
    if (grid == 0) {
        if (n_in != 13 || in_sizes[0] != MROWS * DM || out_size != MROWS * DM || ws_size < WS_END) {
            fprintf(stderr, "kernel_launch: shape/workspace mismatch (n_in %d, in0 %d, out %d, ws %zu, need %zu)\n", n_in, n_in > 0 ? in_sizes[0] : -1, out_size, ws_size, (size_t)WS_END); grid = -1; return; }
        int dev = 0, cus = 0, per_cu = 0;
        hipGetDevice(&dev);
        hipDeviceGetAttribute(&cus, hipDeviceAttributeMultiprocessorCount, dev);
        if (hipFuncSetAttribute((const void*)yoco_fwd, hipFuncAttributeMaxDynamicSharedMemorySize, LDS_BYTES) != hipSuccess) { fprintf(stderr, "kernel_launch: hipFuncSetAttribute failed\n"); grid = -1; return; }
        if (hipOccupancyMaxActiveBlocksPerMultiprocessor(&per_cu, (const void*)yoco_fwd, NWAVES * 64, LDS_BYTES) != hipSuccess || per_cu < 1) { fprintf(stderr, "kernel_launch: occupancy query says %d\n", per_cu); per_cu = 1; }
        (void)hipGetLastError();
        grid = cus * (per_cu > 1 ? 1 : per_cu);
    }
    if (grid < 0) return;
    Params p{};
    p.x = (const float*)d_in[0]; p.a_w_in = (const float*)d_in[1]; p.a_b_in = (const float*)d_in[2]; p.a_vln_g = (const float*)d_in[3]; p.a_vln_b = (const float*)d_in[4];
    p.a_w_s = (const float*)d_in[5]; p.a_b_s = (const float*)d_in[6]; p.a_w_out = (const float*)d_in[7]; p.kv_w = (const float*)d_in[8]; p.b_w_in = (const float*)d_in[9];
    p.b_w_out = (const float*)d_in[10]; p.ln_g = (const float*)d_in[11]; p.ln_b = (const float*)d_in[12]; p.out = (float*)d_out; p.ws = (unsigned char*)d_ws;
    void* args[] = {&p};
    const hipError_t e = hipLaunchCooperativeKernel((const void*)yoco_fwd, dim3(grid), dim3(NWAVES * 64), args, LDS_BYTES, stream);
    if (e != hipSuccess) fprintf(stderr, "kernel_launch: cooperative launch failed: %s (grid %d)\n", hipGetErrorString(e), grid);
}
```

```cpp
#include <hip/hip_runtime.h>
#include <hip/hip_cooperative_groups.h>
#include <cstdio>
#include <cstdint>
namespace cg = cooperative_groups;
namespace pg8 {
#define PG8_LAS __attribute__((address_space(3)))
typedef unsigned short bf16_t;
typedef short bf16x8 __attribute__((ext_vector_type(8)));
typedef float f32x4 __attribute__((ext_vector_type(4)));
typedef unsigned u32x4 __attribute__((ext_vector_type(4)));
constexpr int BM = 256, BK = 64, HALF = 128, HTB = HALF * BK * 2  , STAGE_BYTES = 8 * HTB, NXCD = 8, WGM = 8;

__host__ __device__ __forceinline__ int lds_byte(int r, int c) { const int st = (r >> 4) * 2 + (c >> 5), rr = r & 15, cc = c & 31, ob = rr * 64 + cc * 2; return st * 1024 + (ob ^ (((ob >> 9) & 1) << 5)); }
__host__ __device__ __forceinline__ void stage_rc(int b, int& R, int& C) { const int st = b / 1024, sb = b % 1024, swz = sb ^ (((sb >> 9) & 1) << 5); R = (st >> 1) * 16 + swz / 64; C = (st & 1) * 32 + (swz % 64) / 2; }
__host__ __device__ __forceinline__ int perm32(int rho) { const int n = rho >> 4, i = rho & 15; return 8 * (i >> 2) + 4 * n + (i & 3); }

struct Unit { int pm, pn; };
struct Gemm { const bf16_t* A; const bf16_t* Bt; int M, N, K; };

struct StaticOrder {
    int nM, nN, nwg, G, c;
    __host__ __device__ void init(int M, int N, int G_, int c_) { nM = M / BM; nN = N / BM; nwg = nM * nN; G = G_; c = c_; }
    __host__ __device__ bool next(int i, Unit& u) const {
        const long L = (long)i * G + c; if (L >= nwg) return false;
        int wgid = (int)L; { const int q = nwg / NXCD, r = nwg % NXCD, xcd = wgid % NXCD, off = wgid / NXCD; wgid = (xcd < r ? xcd * (q + 1) : r * (q + 1) + (xcd - r) * q) + off; }
        const int nig = WGM * nN, gid = wgid / nig, fm = gid * WGM, gsz = (nM - fm) < WGM ? (nM - fm) : WGM;
        u.pm = fm + ((wgid % nig) % gsz); u.pn = (wgid % nig) / gsz; return true;
    }
    __device__ __forceinline__ void a_ready(const Unit&) const {}
    __device__ __forceinline__ void done(const Unit&) const {}
};

__device__ __forceinline__ unsigned cvt_pk_bf16(float lo, float hi) { unsigned r; asm volatile("v_cvt_pk_bf16_f32 %0, %1, %2" : "=v"(r) : "v"(lo), "v"(hi)); return r; }
typedef float f32x2 __attribute__((ext_vector_type(2)));
template <class Epi, class Sched, bool ALIGN_EPI = false, bool SP2 = false>
__device__ __forceinline__ void gemm_phase(PG8_LAS unsigned char* lds, const Gemm g, const Sched& S, const Epi& E) {
    int tid_ = threadIdx.x; asm volatile("" : "+v"(tid_));
    const int tid = tid_, wid = __builtin_amdgcn_readfirstlane(tid >> 6), lane = tid & 63, wr = wid >> 2, wc = wid & 3, fr = lane & 15, fq = lane >> 4;
    const int K = g.K, nt = K / BK;
    unsigned voffA[2], voffB[2];
#pragma unroll
    for (int i = 0; i < 2; ++i) { int R, C; stage_rc(tid * 16 + i * 8192, R, C); const int Rb = Epi::PERM ? ((R & ~31) + perm32(R & 31)) : R;
        voffA[i] = (unsigned)(R * K + C) * 2u; voffB[i] = (unsigned)(Rb * K + C) * 2u; }
    const size_t kstep = (size_t)(BK * 2);
    const size_t hstep = (size_t)HALF * K * 2;
    const size_t tstep = 2 * hstep;
    const unsigned ldsw = (unsigned)wid * 1024u;
    const int aoff = lds_byte(wr * 64 + fr, fq * 8), boff = lds_byte(wc * 32 + fr, fq * 8);
#define PG8_SA(b, h) (((b) * 2 + (h)) * HTB)
#define PG8_SB(b, h) ((4 + (b) * 2 + (h)) * HTB)
#define PG8_STAGE(bufoff, gbase, voff) do { _Pragma("unroll") for (int _i = 0; _i < 2; ++_i) \
        __builtin_amdgcn_global_load_lds((const unsigned*)((const char*)(gbase) + (voff)[_i]), (PG8_LAS unsigned*)(lds + (bufoff) + ldsw + _i * 8192), 16, 0, 0); } while (0)
#define PG8_LDA(dst, b, h) do { _Pragma("unroll") for (int m = 0; m < 4; ++m) _Pragma("unroll") for (int k = 0; k < 2; ++k) dst[m][k] = *(const PG8_LAS bf16x8*)(lds + PG8_SA(b, h) + aoff + m * 2048 + k * 1024); } while (0)
#define PG8_LDB(dst, b, h) do { _Pragma("unroll") for (int n = 0; n < 2; ++n) _Pragma("unroll") for (int k = 0; k < 2; ++k) dst[n][k] = *(const PG8_LAS bf16x8*)(lds + PG8_SB(b, h) + boff + n * 2048 + k * 1024); } while (0)
#define PG8_MMA(ai, bj, At, Bt) do { __builtin_amdgcn_s_setprio(1); _Pragma("unroll") for (int m = 0; m < 4; ++m) _Pragma("unroll") for (int n = 0; n < 2; ++n) _Pragma("unroll") for (int k = 0; k < 2; ++k) \
        acc[ai][bj][m][n] = __builtin_amdgcn_mfma_f32_16x16x32_bf16(Bt[n][k], At[m][k], acc[ai][bj][m][n], 0, 0, 0); __builtin_amdgcn_s_setprio(0); } while (0)
#define PG8_WAIT_V(n) asm volatile("s_waitcnt vmcnt(" #n ")" ::: "memory")
#define PG8_WAIT_L(n) asm volatile("s_waitcnt lgkmcnt(" #n ")" ::: "memory")
#define PG8_BAR __builtin_amdgcn_s_barrier()
#define PG8_SCHED __builtin_amdgcn_sched_barrier(0)
    Unit cur, nxt; int ui = 0;
    if (!S.next(0, cur)) return;
    f32x4 acc[2][2][4][2];
#pragma unroll
    for (int a = 0; a < 2; ++a)
#pragma unroll
        for (int b = 0; b < 2; ++b)
#pragma unroll
            for (int m = 0; m < 4; ++m)
#pragma unroll
                for (int n = 0; n < 2; ++n) acc[a][b][m][n] = (f32x4){0.f, 0.f, 0.f, 0.f};
    bf16x8 At[4][2], B0[2][2], B1[2][2];
    const char* cA = (const char*)g.A + (size_t)cur.pm * tstep; const char* cB = (const char*)g.Bt + (size_t)cur.pn * tstep;
    S.a_ready(cur);
    if constexpr (SP2) {
        PG8_STAGE(PG8_SB(0, 0), cB, voffB); PG8_STAGE(PG8_SB(0, 1), cB + hstep, voffB); PG8_STAGE(PG8_SA(0, 0), cA, voffA); PG8_STAGE(PG8_SA(0, 1), cA + hstep, voffA);
        if (wr == 1) PG8_BAR;
        PG8_WAIT_V(2); PG8_BAR;
        PG8_STAGE(PG8_SB(1, 0), cB + kstep, voffB); PG8_STAGE(PG8_SA(1, 0), cA + kstep, voffA); PG8_STAGE(PG8_SB(1, 1), cB + hstep + kstep, voffB);
        PG8_WAIT_V(6); PG8_BAR;
    } else {
        PG8_STAGE(PG8_SB(0, 0), cB, voffB); PG8_STAGE(PG8_SA(0, 0), cA, voffA); PG8_STAGE(PG8_SB(0, 1), cB + hstep, voffB); PG8_STAGE(PG8_SA(0, 1), cA + hstep, voffA);
        if (wr == 1) PG8_BAR;
        PG8_WAIT_V(4); PG8_BAR;
        PG8_STAGE(PG8_SB(1, 0), cB + kstep, voffB); PG8_STAGE(PG8_SA(1, 0), cA + kstep, voffA); PG8_STAGE(PG8_SB(1, 1), cB + hstep + kstep, voffB);
        PG8_WAIT_V(6); PG8_BAR;
    }
    for (;;) {
        const bool has_next = S.next(ui + 1, nxt);
        const char* nA = has_next ? (const char*)g.A + (size_t)nxt.pm * tstep : cA; const char* nB = has_next ? (const char*)g.Bt + (size_t)nxt.pn * tstep : cB;
        for (int t = 0; t < nt; t += 2) {
            const bool last = (t == nt - 2);
            const char* a1 = cA + (size_t)(t + 1) * kstep;
            const char* a2 = last ? nA : cA + (size_t)(t + 2) * kstep; const char* b2 = last ? nB : cB + (size_t)(t + 2) * kstep;
            const char* a3 = a2 + kstep; const char* b3 = b2 + kstep;
            if (last && has_next) S.a_ready(nxt);
            if constexpr (SP2) {
            PG8_LDB(B0, 0, 0); PG8_LDB(B1, 0, 1); PG8_SCHED; PG8_LDA(At, 0, 0); PG8_STAGE(PG8_SA(1, 1), a1 + hstep, voffA);
            PG8_WAIT_V(8); PG8_WAIT_L(0); PG8_BAR; PG8_MMA(0, 0, At, B0); PG8_MMA(0, 1, At, B1); PG8_BAR; PG8_SCHED;
            PG8_LDA(At, 0, 1); PG8_STAGE(PG8_SB(0, 0), b2, voffB); PG8_STAGE(PG8_SB(0, 1), b2 + hstep, voffB); PG8_STAGE(PG8_SA(0, 0), a2, voffA);
            PG8_WAIT_V(8); PG8_WAIT_L(0); PG8_BAR; PG8_MMA(1, 0, At, B0); PG8_MMA(1, 1, At, B1); PG8_BAR; PG8_SCHED;
            PG8_LDB(B0, 1, 0); PG8_LDB(B1, 1, 1); PG8_SCHED; PG8_LDA(At, 1, 0); PG8_STAGE(PG8_SA(0, 1), a2 + hstep, voffA);
            PG8_WAIT_V(8); PG8_WAIT_L(0); PG8_BAR; PG8_MMA(0, 0, At, B0); PG8_MMA(0, 1, At, B1); PG8_BAR; PG8_SCHED;
            PG8_LDA(At, 1, 1); PG8_STAGE(PG8_SB(1, 0), b3, voffB); PG8_STAGE(PG8_SB(1, 1), b3 + hstep, voffB); PG8_STAGE(PG8_SA(1, 0), a3, voffA);
            PG8_WAIT_V(8); PG8_WAIT_L(0); PG8_BAR; PG8_MMA(1, 0, At, B0); PG8_MMA(1, 1, At, B1); PG8_BAR; PG8_SCHED;
            } else {
            PG8_LDB(B0, 0, 0); PG8_SCHED; PG8_LDA(At, 0, 0); PG8_STAGE(PG8_SA(1, 1), a1 + hstep, voffA);
            PG8_WAIT_L(8); PG8_BAR; PG8_WAIT_L(0); PG8_MMA(0, 0, At, B0); PG8_BAR; PG8_SCHED;
            PG8_LDB(B1, 0, 1); PG8_STAGE(PG8_SB(0, 0), b2, voffB);
            PG8_BAR; PG8_WAIT_L(0); PG8_MMA(0, 1, At, B1); PG8_BAR;
            PG8_LDA(At, 0, 1); PG8_STAGE(PG8_SA(0, 0), a2, voffA);
            PG8_BAR; PG8_WAIT_L(0); PG8_MMA(1, 0, At, B0); PG8_BAR; PG8_SCHED;
            PG8_STAGE(PG8_SB(0, 1), b2 + hstep, voffB);
            PG8_WAIT_V(6); PG8_BAR; PG8_MMA(1, 1, At, B1); PG8_BAR;
            PG8_LDB(B0, 1, 0); PG8_SCHED; PG8_LDA(At, 1, 0); PG8_STAGE(PG8_SA(0, 1), a2 + hstep, voffA);
            PG8_WAIT_L(8); PG8_BAR; PG8_WAIT_L(0); PG8_MMA(0, 0, At, B0); PG8_BAR; PG8_SCHED;
            PG8_LDB(B1, 1, 1); PG8_STAGE(PG8_SB(1, 0), b3, voffB);
            PG8_BAR; PG8_WAIT_L(0); PG8_MMA(0, 1, At, B1); PG8_BAR;
            PG8_LDA(At, 1, 1); PG8_STAGE(PG8_SA(1, 0), a3, voffA);
            PG8_BAR; PG8_WAIT_L(0); PG8_MMA(1, 0, At, B0); PG8_BAR; PG8_SCHED;
            PG8_STAGE(PG8_SB(1, 1), b3 + hstep, voffB);
            PG8_WAIT_V(6); PG8_BAR; PG8_MMA(1, 1, At, B1); PG8_BAR;
            }
        }
        if constexpr (ALIGN_EPI) { if (wr == 0) PG8_BAR; }
        if constexpr (!Epi::AFTER_DRAIN) { E(acc, cur, wr, wc, fr, fq); S.done(cur); }
        if (!has_next) break;
#pragma unroll
        for (int a = 0; a < 2; ++a)
#pragma unroll
            for (int b = 0; b < 2; ++b)
#pragma unroll
                for (int m = 0; m < 4; ++m)
#pragma unroll
                    for (int n = 0; n < 2; ++n) acc[a][b][m][n] = (f32x4){0.f, 0.f, 0.f, 0.f};
        cur = nxt; cA = nA; cB = nB; ++ui;
        if constexpr (ALIGN_EPI) { if (wr == 1) PG8_BAR; }
    }
    PG8_WAIT_V(0);
    if constexpr (!ALIGN_EPI) { if (wr == 0) PG8_BAR; }
    PG8_BAR;
    if constexpr (Epi::AFTER_DRAIN) { E.fused(acc, cur, wr, wc, fr, fq, lds, wid, lane); S.done(cur); }
#undef PG8_SA
#undef PG8_SB
#undef PG8_STAGE
#undef PG8_LDA
#undef PG8_LDB
#undef PG8_MMA
#undef PG8_WAIT_V
#undef PG8_WAIT_L
#undef PG8_BAR
#undef PG8_SCHED
}
}

constexpr int DM = 2048, SEQ = 4096, NB = 2, MROWS = NB * SEQ;
constexpr int AW = 4096, NG = 8, GD = 512, CH = 128;
constexpr int NH = 16, HD = 128;
constexpr float LN_EPS = 1e-5f;
constexpr float DN_ALPHA = 1.4142135623730951f;
constexpr float QSCALE = 0.08838834764831845f * 1.4426950408889634f;

#define LAS __attribute__((address_space(3)))
typedef unsigned short bf16;
typedef float f32x4 __attribute__((ext_vector_type(4)));
typedef float f32x2 __attribute__((ext_vector_type(2)));
typedef float f32x16 __attribute__((ext_vector_type(16)));
typedef short bf16x8 __attribute__((ext_vector_type(8)));
typedef short s16x4 __attribute__((ext_vector_type(4)));
typedef unsigned u32x4 __attribute__((ext_vector_type(4)));
typedef unsigned u32x2 __attribute__((ext_vector_type(2)));

__device__ __forceinline__ int opaque_tid() { int t = threadIdx.x; asm volatile("" : "+v"(t)); return t; }
__device__ __forceinline__ unsigned cvtpk(float lo, float hi) { unsigned r; asm volatile("v_cvt_pk_bf16_f32 %0, %1, %2" : "=v"(r) : "v"(lo), "v"(hi)); return r; }
__device__ __forceinline__ float bf2f(unsigned short b) { return __uint_as_float(((unsigned)b) << 16); }
__device__ __forceinline__ float gelu_tanh(float x) { const float t = x * (1.f + 0.044715f * x * x) * 2.302208198f; return x * __builtin_amdgcn_rcpf(1.f + __builtin_amdgcn_exp2f(-t)); }
__device__ __forceinline__ float silu_f(float x) { return x * __builtin_amdgcn_rcpf(1.f + __builtin_amdgcn_exp2f(-1.4426950408889634f * x)); }

namespace pg8 {
__device__ __forceinline__ f32x4 gelu4(f32x4 v) { return (f32x4){gelu_tanh(v[0]), gelu_tanh(v[1]), gelu_tanh(v[2]), gelu_tanh(v[3])}; }
__device__ __forceinline__ f32x4 silu4(f32x4 v) { return (f32x4){silu_f(v[0]), silu_f(v[1]), silu_f(v[2]), silu_f(v[3])}; }
struct EpiG1 {
    static constexpr bool PERM = true, AFTER_DRAIN = false;
    bf16_t* base; size_t rstride; float* stats; const float* bias;
    __device__ __forceinline__ void operator()(const f32x4 (&acc)[2][2][4][2], const Unit& u, int wr, int wc, int fr, int fq) const {
        const int region = u.pn >> 4, pnr = u.pn & 15;
        const int col0 = pnr * BM + wc * 32 + 8 * fq, bcol0 = u.pn * BM + wc * 32 + 8 * fq;
        f32x4 bv[2][2];
#pragma unroll
        for (int bj = 0; bj < 2; ++bj)
#pragma unroll
            for (int n = 0; n < 2; ++n) bv[bj][n] = *(const f32x4*)(bias + bcol0 + bj * HALF + 4 * n);
#pragma unroll
        for (int ai = 0; ai < 2; ++ai)
#pragma unroll
            for (int m = 0; m < 4; ++m) {
                const int row = u.pm * BM + ai * HALF + wr * 64 + m * 16 + fr;
                float s = 0.f, ss = 0.f;
#pragma unroll
                for (int bj = 0; bj < 2; ++bj) {
                    f32x4 a0 = acc[ai][bj][m][0] + bv[bj][0], a1 = acc[ai][bj][m][1] + bv[bj][1];
                    if (region == 2) { a0 = silu4(a0); a1 = silu4(a1); } else { a0 = gelu4(a0); a1 = gelu4(a1); }
                    u32x4 w; w.x = cvtpk(a0[0], a0[1]); w.y = cvtpk(a0[2], a0[3]); w.z = cvtpk(a1[0], a1[1]); w.w = cvtpk(a1[2], a1[3]);
                    if (region == 1) {
                        s += ((a0[0] + a0[1]) + (a0[2] + a0[3])) + ((a1[0] + a1[1]) + (a1[2] + a1[3]));
                        ss += ((a0[0] * a0[0] + a0[1] * a0[1]) + (a0[2] * a0[2] + a0[3] * a0[3])) + ((a1[0] * a1[0] + a1[1] * a1[1]) + (a1[2] * a1[2] + a1[3] * a1[3]));
                        bf16_t* tp = base + rstride + ((size_t)(row >> 7) * AW + col0 + bj * HALF) * CH + (row & 127);
                        tp[0 * CH] = (bf16_t)(w.x & 0xffffu); tp[1 * CH] = (bf16_t)(w.x >> 16); tp[2 * CH] = (bf16_t)(w.y & 0xffffu); tp[3 * CH] = (bf16_t)(w.y >> 16);
                        tp[4 * CH] = (bf16_t)(w.z & 0xffffu); tp[5 * CH] = (bf16_t)(w.z >> 16); tp[6 * CH] = (bf16_t)(w.w & 0xffffu); tp[7 * CH] = (bf16_t)(w.w >> 16);
                    } else {
                        bf16_t* dst = base + (size_t)region * rstride + (size_t)row * AW + col0 + bj * HALF;
                        *(u32x4*)dst = w;
                    }
                }
                if (region == 1) {
                    s += __shfl_xor(s, 16); s += __shfl_xor(s, 32); ss += __shfl_xor(ss, 16); ss += __shfl_xor(ss, 32);
                    if (fq == 0) *(f32x2*)(stats + ((size_t)row * 64 + pnr * 4 + wc) * 2) = (f32x2){s, ss};
                }
            }
    }
};
struct EpiG3 {
    static constexpr bool PERM = true, AFTER_DRAIN = false;
    bf16_t* base; size_t rstride;
    __device__ __forceinline__ void operator()(const f32x4 (&acc)[2][2][4][2], const Unit& u, int wr, int wc, int fr, int fq) const {
        const int region = u.pn >> 3, pnr = u.pn & 7;
        const int col0 = pnr * BM + wc * 32 + 8 * fq;
#pragma unroll
        for (int ai = 0; ai < 2; ++ai)
#pragma unroll
            for (int m = 0; m < 4; ++m) {
                const int row = u.pm * BM + ai * HALF + wr * 64 + m * 16 + fr;
#pragma unroll
                for (int bj = 0; bj < 2; ++bj) {
                    f32x4 a0 = acc[ai][bj][m][0], a1 = acc[ai][bj][m][1];
                    if (region == 3) { a0 = silu4(a0); a1 = silu4(a1); } else if (region == 2) { a0 = a0 * QSCALE; a1 = a1 * QSCALE; }
                    u32x4 w; w.x = cvtpk(a0[0], a0[1]); w.y = cvtpk(a0[2], a0[3]); w.z = cvtpk(a1[0], a1[1]); w.w = cvtpk(a1[2], a1[3]);
                    if (region == 1) {
                        bf16_t* tp = base + rstride + ((size_t)(row >> 12) * DM + col0 + bj * HALF) * SEQ + (row & (SEQ - 1));
                        tp[0 * SEQ] = (bf16_t)(w.x & 0xffffu); tp[1 * SEQ] = (bf16_t)(w.x >> 16); tp[2 * SEQ] = (bf16_t)(w.y & 0xffffu); tp[3 * SEQ] = (bf16_t)(w.y >> 16);
                        tp[4 * SEQ] = (bf16_t)(w.z & 0xffffu); tp[5 * SEQ] = (bf16_t)(w.z >> 16); tp[6 * SEQ] = (bf16_t)(w.w & 0xffffu); tp[7 * SEQ] = (bf16_t)(w.w >> 16);
                    } else {
                        bf16_t* dst = base + (size_t)region * rstride + (size_t)row * DM + col0 + bj * HALF;
                        *(u32x4*)dst = w;
                    }
                }
            }
    }
};
struct EpiRes {
    static constexpr bool PERM = false, AFTER_DRAIN = false;
    const float* X; float* Z;
    __device__ __forceinline__ void operator()(const f32x4 (&acc)[2][2][4][2], const Unit& u, int wr, int wc, int fr, int fq) const {
        const int col0 = u.pn * BM + wc * 32 + 4 * fq;
#pragma unroll
        for (int ai = 0; ai < 2; ++ai)
#pragma unroll
            for (int m = 0; m < 4; ++m) {
                const size_t off = (size_t)(u.pm * BM + ai * HALF + wr * 64 + m * 16 + fr) * DM + col0;
#pragma unroll
                for (int bj = 0; bj < 2; ++bj)
#pragma unroll
                    for (int n = 0; n < 2; ++n) { const f32x4 xv = *(const f32x4*)(X + off + bj * HALF + n * 16); *(f32x4*)(Z + off + bj * HALF + n * 16) = xv * DN_ALPHA + acc[ai][bj][m][n]; }
            }
    }
};
}

constexpr size_t MiB = 1u << 20;
constexpr size_t WS_W2T = 0 * MiB;
constexpr size_t WS_W3T = 16 * MiB;
constexpr size_t WS_W4T = 48 * MiB;
constexpr size_t WS_W1T = 56 * MiB;
constexpr size_t WS_XB  = 104 * MiB;
constexpr size_t WS_SM  = 56 * MiB;
constexpr size_t WS_U   = 136 * MiB;
constexpr size_t WS_GVT = 200 * MiB;
constexpr size_t WS_SG  = 264 * MiB;
constexpr size_t WS_ST  = 328 * MiB;
constexpr size_t WS_Z   = 136 * MiB;
constexpr size_t WS_X1  = 200 * MiB;
constexpr size_t WS_X1B = 264 * MiB;
constexpr size_t WS_KB  = 56 * MiB;
constexpr size_t WS_VT  = 88 * MiB;
constexpr size_t WS_QB  = 120 * MiB;
constexpr size_t WS_SGB = 152 * MiB;
constexpr size_t WS_OG  = 296 * MiB;
constexpr size_t WS_Z2  = 56 * MiB;
constexpr size_t WS_END = 332 * MiB;
static_assert(WS_SG - WS_GVT == WS_GVT - WS_U && WS_VT - WS_KB == WS_QB - WS_VT && WS_SGB - WS_QB == WS_VT - WS_KB, "region strides");

constexpr int LDS_BYTES = 147456;
constexpr int NWAVES = 8;

struct Params {
    const float* x; const float* a_w_in; const float* a_b_in; const float* a_vln_g; const float* a_vln_b; const float* a_w_s; const float* a_b_s; const float* a_w_out;
    const float* kv_w; const float* b_w_in; const float* b_w_out; const float* ln_g; const float* ln_b;
    float* out; unsigned char* ws;
};

__device__ __forceinline__ void p0_transpose_item(const float* W, int K, int N, bf16* WT, int row_off, LAS float* scr, int item, int lane) {
    const int nblk = N / 64, kb = item / nblk, nb = item % nblk, k0 = 64 * kb, n0 = 64 * nb;
    const int lr = lane >> 4, lc = (lane & 15) * 4;
    f32x4 v[16];
#pragma unroll
    for (int i = 0; i < 16; ++i) v[i] = __builtin_nontemporal_load((const f32x4*)(W + (size_t)(k0 + 4 * i + lr) * N + n0 + lc));
#pragma unroll
    for (int i = 0; i < 16; ++i) { LAS float* d = scr + (4 * i + lr) * 65 + lc; d[0] = v[i][0]; d[1] = v[i][1]; d[2] = v[i][2]; d[3] = v[i][3]; }
    asm volatile("s_waitcnt lgkmcnt(0)" ::: "memory");
    const int c = lane & 7;
#pragma unroll
    for (int j = 0; j < 8; ++j) { const int n = (lane >> 3) + 8 * j; const LAS float* s = scr + (8 * c) * 65 + n;
        u32x4 o; o.x = cvtpk(s[0 * 65], s[1 * 65]); o.y = cvtpk(s[2 * 65], s[3 * 65]); o.z = cvtpk(s[4 * 65], s[5 * 65]); o.w = cvtpk(s[6 * 65], s[7 * 65]);
        *(u32x4*)(WT + (size_t)(row_off + n0 + n) * K + k0 + 8 * c) = o; }
    asm volatile("s_waitcnt lgkmcnt(0)" ::: "memory");
}
__device__ __forceinline__ void p0_phase(LAS unsigned char* lds, const Params& p, int G) {
    const int tid = opaque_tid(), lane = tid & 63, wave = tid >> 6;
    LAS float* scr = (LAS float*)(lds + wave * 16640);
    const int gw = blockIdx.x * NWAVES + wave, NGW = G * NWAVES;
    constexpr int I_1 = (DM / 64) * (3 * AW / 64), I_2 = (AW / 64) * (DM / 64), I_KV = (DM / 64) * (2 * DM / 64), I_BI = I_KV, I_BO = (DM / 64) * (DM / 64);
    constexpr int NITEMS = I_1 + I_2 + I_KV + I_BI + I_BO;
    bf16* W1T = (bf16*)(p.ws + WS_W1T); bf16* W2T = (bf16*)(p.ws + WS_W2T); bf16* W3T = (bf16*)(p.ws + WS_W3T); bf16* W4T = (bf16*)(p.ws + WS_W4T);
    for (int it = gw; it < NITEMS; it += NGW) {
        int r = it;
        if (r < I_1) { p0_transpose_item(p.a_w_in, DM, 3 * AW, W1T, 0, scr, r, lane); continue; } r -= I_1;
        if (r < I_2) { p0_transpose_item(p.a_w_out, AW, DM, W2T, 0, scr, r, lane); continue; } r -= I_2;
        if (r < I_KV) { p0_transpose_item(p.kv_w, DM, 2 * DM, W3T, 0, scr, r, lane); continue; } r -= I_KV;
        if (r < I_BI) { p0_transpose_item(p.b_w_in, DM, 2 * DM, W3T, 2 * DM, scr, r, lane); continue; } r -= I_BI;
        p0_transpose_item(p.b_w_out, DM, DM, W4T, 0, scr, r, lane);
    }
    bf16* XB = (bf16*)(p.ws + WS_XB);
    const size_t n8 = (size_t)MROWS * DM / 8, step = (size_t)G * 512;
    for (size_t i0 = (size_t)blockIdx.x * 512 + tid; i0 < n8; i0 += 4 * step) {
        f32x4 a[4], b[4];
#pragma unroll
        for (int k = 0; k < 4; ++k) { const size_t i = i0 + k * step; if (i < n8) { a[k] = __builtin_nontemporal_load((const f32x4*)(p.x + i * 8)); b[k] = __builtin_nontemporal_load((const f32x4*)(p.x + i * 8 + 4)); } }
#pragma unroll
        for (int k = 0; k < 4; ++k) { const size_t i = i0 + k * step; if (i < n8) {
            u32x4 o; o.x = cvtpk(a[k][0], a[k][1]); o.y = cvtpk(a[k][2], a[k][3]); o.z = cvtpk(b[k][0], b[k][1]); o.w = cvtpk(b[k][2], b[k][3]);
            *(u32x4*)(XB + i * 8) = o; } }
    }
}

__device__ __forceinline__ void mix_phase(LAS unsigned char* lds, const Params& p, int job_lo, int job_step) {
    constexpr int TP = 272;
    constexpr int OFF_A = 0, OFF_B = 128 * TP, OFF_MU = 2 * 128 * TP, OFF_RS = OFF_MU + 512, OFF_C1 = OFF_RS + 512, OFF_C2 = OFF_C1 + 512;
    const int tid = opaque_tid(), lane = tid & 63, wid = tid >> 6, wr = wid >> 2, wc = wid & 3, fr = lane & 15, fq = lane >> 4;
    const bf16* U = (const bf16*)(p.ws + WS_U); const bf16* GVt = (const bf16*)(p.ws + WS_GVT); const bf16* SG = (const bf16*)(p.ws + WS_SG);
    const float* stats = (const float*)(p.ws + WS_ST); bf16* SM = (bf16*)(p.ws + WS_SM);
    LAS float* mu = (LAS float*)(lds + OFF_MU); LAS float* rs = (LAS float*)(lds + OFF_RS); LAS float* c1s = (LAS float*)(lds + OFF_C1); LAS float* c2s = (LAS float*)(lds + OFF_C2);
    for (int job = job_lo; job < 256; job += job_step) {
        const int chunk = job >> 2, part = job & 3;
        __syncthreads();
        {
            const int row = tid >> 2, q = tid & 3;
            const f32x2* sp = (const f32x2*)stats + ((size_t)(chunk * CH + row) * 64 + q * 16);
            float s = 0.f, ss = 0.f;
#pragma unroll
            for (int i = 0; i < 16; ++i) { const f32x2 v = sp[i]; s += v.x; ss += v.y; }
            s += __shfl_xor(s, 1); s += __shfl_xor(s, 2); ss += __shfl_xor(ss, 1); ss += __shfl_xor(ss, 2);
            const float mean = s * (1.f / AW), var = ss * (1.f / AW) - mean * mean;
            if (q == 0) { mu[row] = mean; rs[row] = 1.0f / sqrtf(var + LN_EPS); }
        }
        __syncthreads();
        for (int gi = 0; gi < 2; ++gi) {
            const int g = part * 2 + gi;
            __syncthreads();
            {
                const int t = tid >> 2, q = tid & 3;
                const float* wrow = p.a_w_s + ((size_t)g * CH + t) * CH + q * 32;
                float c1 = 0.f, c2 = 0.f;
#pragma unroll
                for (int i = 0; i < 4; ++i) {
                    const f32x4 w0 = *(const f32x4*)(wrow + i * 8), w1 = *(const f32x4*)(wrow + i * 8 + 4);
                    float w[8] = {w0[0], w0[1], w0[2], w0[3], w1[0], w1[1], w1[2], w1[3]};
                    float wp[8];
#pragma unroll
                    for (int j = 0; j < 8; ++j) { const int s = q * 32 + i * 8 + j; const float wm = (s <= t) ? w[j] : 0.f; c2 += wm; wp[j] = wm * rs[s]; }
                    u32x4 o; o.x = cvtpk(wp[0], wp[1]); o.y = cvtpk(wp[2], wp[3]); o.z = cvtpk(wp[4], wp[5]); o.w = cvtpk(wp[6], wp[7]);
#pragma unroll
                    for (int j = 0; j < 4; ++j) { const unsigned pk = o[j]; const int s = q * 32 + i * 8 + 2 * j; c1 += __uint_as_float(pk << 16) * mu[s] + __uint_as_float(pk & 0xffff0000u) * mu[s + 1]; }
                    *(LAS u32x4*)(lds + OFF_A + t * TP + (q * 32 + i * 8) * 2) = o;
                }
                c1 += __shfl_xor(c1, 1); c1 += __shfl_xor(c1, 2); c2 += __shfl_xor(c2, 1); c2 += __shfl_xor(c2, 2);
                if (q == 0) { c1s[t] = c1; c2s[t] = c2; }
            }
            for (int eb = 0; eb < 4; ++eb) {
                const int ecol0 = g * GD + eb * 128;
                __syncthreads();
                {
                    const int er = tid >> 2, pc = tid & 3;
                    const bf16* src = GVt + ((size_t)chunk * AW + ecol0 + er) * CH + pc * 32;
                    const u32x4 b0 = *(const u32x4*)(src), b1 = *(const u32x4*)(src + 8), b2 = *(const u32x4*)(src + 16), b3 = *(const u32x4*)(src + 24);
                    LAS unsigned char* d = lds + OFF_B + er * TP + pc * 64;
                    *(LAS u32x4*)(d) = b0; *(LAS u32x4*)(d + 16) = b1; *(LAS u32x4*)(d + 32) = b2; *(LAS u32x4*)(d + 48) = b3;
                }
                __syncthreads();
                f32x4 acc[4][2];
#pragma unroll
                for (int m = 0; m < 4; ++m)
#pragma unroll
                    for (int n = 0; n < 2; ++n) acc[m][n] = (f32x4){0.f, 0.f, 0.f, 0.f};
#pragma unroll
                for (int k = 0; k < 4; ++k) {
                    bf16x8 af[4], bfr[2];
#pragma unroll
                    for (int m = 0; m < 4; ++m) af[m] = *(const LAS bf16x8*)(lds + OFF_A + (wr * 64 + m * 16 + fr) * TP + (k * 32 + fq * 8) * 2);
#pragma unroll
                    for (int n = 0; n < 2; ++n) { const int erow = wc * 32 + 8 * (fr >> 2) + 4 * n + (fr & 3); bfr[n] = *(const LAS bf16x8*)(lds + OFF_B + erow * TP + (k * 32 + fq * 8) * 2); }
#pragma unroll
                    for (int m = 0; m < 4; ++m)
#pragma unroll
                        for (int n = 0; n < 2; ++n) acc[m][n] = __builtin_amdgcn_mfma_f32_16x16x32_bf16(bfr[n], af[m], acc[m][n], 0, 0, 0);
                }
                const int ec = ecol0 + wc * 32 + 8 * fq;
                const f32x4 g0 = *(const f32x4*)(p.a_vln_g + ec), g1 = *(const f32x4*)(p.a_vln_g + ec + 4), be0 = *(const f32x4*)(p.a_vln_b + ec), be1 = *(const f32x4*)(p.a_vln_b + ec + 4);
#pragma unroll
                for (int m = 0; m < 4; ++m) {
                    const int t = wr * 64 + m * 16 + fr; const size_t off = (size_t)(chunk * CH + t) * AW + ec;
                    const float c1 = c1s[t], c2 = c2s[t], bs = p.a_b_s[g * CH + t];
                    const u32x4 uu = *(const u32x4*)(U + off), sg = *(const u32x4*)(SG + off);
                    const f32x4 m0 = g0 * (acc[m][0] - c1) + be0 * c2 + bs, m1 = g1 * (acc[m][1] - c1) + be1 * c2 + bs;
                    float r[8];
#pragma unroll
                    for (int j = 0; j < 4; ++j) {
                        const float mlo = (j < 2) ? m0[2 * j] : m1[2 * j - 4], mhi = (j < 2) ? m0[2 * j + 1] : m1[2 * j - 3];
                        r[2 * j] = __uint_as_float(uu[j] << 16) * mlo * __uint_as_float(sg[j] << 16);
                        r[2 * j + 1] = __uint_as_float(uu[j] & 0xffff0000u) * mhi * __uint_as_float(sg[j] & 0xffff0000u);
                    }
                    u32x4 o; o.x = cvtpk(r[0], r[1]); o.y = cvtpk(r[2], r[3]); o.z = cvtpk(r[4], r[5]); o.w = cvtpk(r[6], r[7]);
                    *(u32x4*)(SM + off) = o;
                }
            }
        }
    }
}

__device__ __forceinline__ void ln_phase(const float* Z, const float* gam, const float* bet, float* Xout, bf16* Xb, int G) {
    const int tid = opaque_tid(), lane = tid & 63, wave = tid >> 6;
    f32x4 gv[8], bv[8];
#pragma unroll
    for (int j = 0; j < 8; ++j) { gv[j] = *(const f32x4*)(gam + (64 * j + lane) * 4); bv[j] = *(const f32x4*)(bet + (64 * j + lane) * 4); }
    for (int row = blockIdx.x * NWAVES + wave; row < MROWS; row += G * NWAVES) {
        const f32x4* zr = (const f32x4*)(Z + (size_t)row * DM) + lane;
        f32x4 v[8]; float s = 0.f;
#pragma unroll
        for (int j = 0; j < 8; ++j) { v[j] = zr[64 * j]; s += (v[j][0] + v[j][1]) + (v[j][2] + v[j][3]); }
#pragma unroll
        for (int o = 1; o < 64; o <<= 1) s += __shfl_xor(s, o);
        const float mean = s * (1.f / DM); float s2 = 0.f;
#pragma unroll
        for (int j = 0; j < 8; ++j) { v[j] = v[j] - mean; s2 += (v[j][0] * v[j][0] + v[j][1] * v[j][1]) + (v[j][2] * v[j][2] + v[j][3] * v[j][3]); }
#pragma unroll
        for (int o = 1; o < 64; o <<= 1) s2 += __shfl_xor(s2, o);
        const float rstd = 1.0f / sqrtf(s2 * (1.f / DM) + LN_EPS);
#pragma unroll
        for (int j = 0; j < 8; ++j) {
            const f32x4 y = v[j] * rstd * gv[j] + bv[j];
            *((f32x4*)(Xout + (size_t)row * DM) + 64 * j + lane) = y;
            if (Xb) { u32x2 w; w.x = cvtpk(y[0], y[1]); w.y = cvtpk(y[2], y[3]); *((u32x2*)(Xb + (size_t)row * DM) + 64 * j + lane) = w; }
        }
    }
}

namespace sba {
constexpr int KP = 272, VP = 136;
constexpr int KSB = 64 * KP, VSB = 128 * VP;
constexpr int OFF_K = 0, OFF_V = 2 * KSB, OFF_FLAG = 2 * KSB + 2 * VSB;
#ifndef SBA_EARLY_EXIT
#define SBA_EARLY_EXIT 1
#endif
__device__ __forceinline__ int crow(int r, int hi) { return (r & 3) + 8 * (r >> 2) + 4 * hi; }
__device__ __forceinline__ void sb_block(f32x16& p, float& c, int kbase, int trow, int hi, bool band) {
    float sfx[16];
#pragma unroll
    for (int r = 0; r < 16; ++r) {
        float e = __builtin_amdgcn_exp2f(__builtin_fminf(p[r], 100.f));
        if (band) { const int key = kbase + crow(r, hi); e = (key < trow) ? e : 0.f; }
        p[r] = e; sfx[r] = 1.f + e;
    }
    float lo[4], hh[4];
#pragma unroll
    for (int k = 0; k < 4; ++k) {
        sfx[4 * k + 2] *= sfx[4 * k + 3]; sfx[4 * k + 1] *= sfx[4 * k + 2]; sfx[4 * k] *= sfx[4 * k + 1];
        const unsigned tb = __float_as_uint(sfx[4 * k]);
        auto rr = __builtin_amdgcn_permlane32_swap(tb, tb, false, false);
        lo[k] = __uint_as_float(rr[0]); hh[k] = __uint_as_float(rr[1]);
    }
    float E[4];
#pragma unroll
    for (int k = 3; k >= 0; --k) { const float eh = c; c *= hh[k]; const float el = c; c *= lo[k]; E[k] = hi ? eh : el; }
#pragma unroll
    for (int r = 0; r < 16; ++r) p[r] = p[r] * __builtin_amdgcn_rcpf(sfx[r] * E[r >> 2]);
}
__device__ __forceinline__ void attn_unit(LAS unsigned char* lds, int b, int h, int qb, const bf16* Qb, const bf16* Kb, const bf16* Vt, const bf16* SGb, bf16* OG) {
    const int tid = opaque_tid(), lane = tid & 63, r32 = lane & 31, hi = lane >> 5;
    const int wid = __builtin_amdgcn_readfirstlane(tid >> 6);
    const int t0 = qb * 256, tw0 = t0 + wid * 32, trow = tw0 + r32;
    const size_t rowbase = (size_t)b * SEQ;
    bf16x8 qr[8];
    { const bf16* qp = Qb + (rowbase + trow) * DM + h * HD + hi * 8;
#pragma unroll
      for (int d0 = 0; d0 < 8; ++d0) qr[d0] = *(const bf16x8*)(qp + d0 * 16); }
    f32x16 o[4];
#pragma unroll
    for (int i = 0; i < 4; ++i)
#pragma unroll
        for (int r = 0; r < 16; ++r) o[i][r] = 0.f;
    float R = 1.f;
    const int krow = tid >> 3, kpc = tid & 7, vrow = tid >> 2, vpc = tid & 3;
    const bf16* kg = Kb + (rowbase + krow) * DM + h * HD + kpc * 16;
    const bf16* vg = Vt + ((size_t)(b * NH + h) * HD + vrow) * SEQ + vpc * 16;
    LAS unsigned char* kdst = lds + OFF_K + krow * KP + kpc * 32;
    LAS unsigned char* vdst = lds + OFF_V + vrow * VP + vpc * 32;
    LAS unsigned* flags = (LAS unsigned*)(lds + OFF_FLAG);
    const int jmax = 4 * qb + 3;
    u32x4 kr0, kr1, vr0, vr1;
#define SBA_LOAD(j) do { const bf16* kp_ = kg + (size_t)(j) * 64 * DM; kr0 = *(const u32x4*)kp_; kr1 = *(const u32x4*)(kp_ + 8); const bf16* vp_ = vg + (j) * 64; vr0 = *(const u32x4*)vp_; vr1 = *(const u32x4*)(vp_ + 8); } while (0)
#define SBA_STORE(bf) do { LAS unsigned char* kd_ = kdst + (bf) * KSB; *(LAS u32x4*)kd_ = kr0; *(LAS u32x4*)(kd_ + 16) = kr1; LAS unsigned char* vd_ = vdst + (bf) * VSB; \
        *(LAS u32x2*)vd_ = (u32x2){vr0.x, vr0.y}; *(LAS u32x2*)(vd_ + 8) = (u32x2){vr0.z, vr0.w}; *(LAS u32x2*)(vd_ + 16) = (u32x2){vr1.x, vr1.y}; *(LAS u32x2*)(vd_ + 24) = (u32x2){vr1.z, vr1.w}; } while (0)
    SBA_LOAD(jmax); SBA_STORE(0);
    __syncthreads();
    bool wdone = false;
    for (int j = jmax, it = 0;; --j, ++it) {
        const int buf = it & 1;
        if (j > 0) SBA_LOAD(j - 1);
        const int k0 = 64 * j;
        if (k0 < tw0 + 32 && !wdone) {
            const LAS unsigned char* kb = lds + OFF_K + buf * KSB + r32 * KP + hi * 16;
            f32x16 p0, p1;
#pragma unroll
            for (int r = 0; r < 16; ++r) { p0[r] = 0.f; p1[r] = 0.f; }
#pragma unroll
            for (int d0 = 0; d0 < 8; ++d0) {
                const bf16x8 k0f = *(const LAS bf16x8*)(kb + d0 * 32), k1f = *(const LAS bf16x8*)(kb + 32 * KP + d0 * 32);
                p0 = __builtin_amdgcn_mfma_f32_32x32x16_bf16(k0f, qr[d0], p0, 0, 0, 0);
                p1 = __builtin_amdgcn_mfma_f32_32x32x16_bf16(k1f, qr[d0], p1, 0, 0, 0);
            }
            const bool band = (k0 + 63 >= tw0);
            sb_block(p1, R, k0 + 32, trow, hi, band);
            sb_block(p0, R, k0, trow, hi, band);
            bf16x8 pw[4];
            { u32x4 w;
              w.x = cvtpk(p0[0], p0[1]); w.y = cvtpk(p0[2], p0[3]); w.z = cvtpk(p0[4], p0[5]); w.w = cvtpk(p0[6], p0[7]); pw[0] = __builtin_bit_cast(bf16x8, w);
              w.x = cvtpk(p0[8], p0[9]); w.y = cvtpk(p0[10], p0[11]); w.z = cvtpk(p0[12], p0[13]); w.w = cvtpk(p0[14], p0[15]); pw[1] = __builtin_bit_cast(bf16x8, w);
              w.x = cvtpk(p1[0], p1[1]); w.y = cvtpk(p1[2], p1[3]); w.z = cvtpk(p1[4], p1[5]); w.w = cvtpk(p1[6], p1[7]); pw[2] = __builtin_bit_cast(bf16x8, w);
              w.x = cvtpk(p1[8], p1[9]); w.y = cvtpk(p1[10], p1[11]); w.z = cvtpk(p1[12], p1[13]); w.w = cvtpk(p1[14], p1[15]); pw[3] = __builtin_bit_cast(bf16x8, w); }
            const LAS unsigned char* vb = lds + OFF_V + buf * VSB + r32 * VP + hi * 8;
            s16x4 va[4][2], vc[4][2];
#define SBA_VLD(dst, ks) do { _Pragma("unroll") for (int db = 0; db < 4; ++db) { dst[db][0] = *(const LAS s16x4*)(vb + db * 32 * VP + (ks) * 32); dst[db][1] = *(const LAS s16x4*)(vb + db * 32 * VP + (ks) * 32 + 16); } } while (0)
#define SBA_PV(src, ks) do { _Pragma("unroll") for (int db = 0; db < 4; ++db) { const bf16x8 vf = (bf16x8){src[db][0][0], src[db][0][1], src[db][0][2], src[db][0][3], src[db][1][0], src[db][1][1], src[db][1][2], src[db][1][3]}; \
                o[db] = __builtin_amdgcn_mfma_f32_32x32x16_bf16(pw[ks], vf, o[db], 0, 0, 0); } } while (0)
#define SBA_SB() __builtin_amdgcn_sched_barrier(0)
            SBA_VLD(va, 0); SBA_VLD(vc, 1); SBA_SB();
            SBA_PV(va, 0); SBA_SB(); SBA_VLD(va, 2); SBA_SB();
            SBA_PV(vc, 1); SBA_SB(); SBA_VLD(vc, 3); SBA_SB();
            SBA_PV(va, 2); SBA_SB();
            SBA_PV(vc, 3); SBA_SB();
#undef SBA_SB
#undef SBA_VLD
#undef SBA_PV
#if SBA_EARLY_EXIT
            wdone = __all(R > 1e30f);
#endif
        }
        if (j > 0) SBA_STORE(buf ^ 1);
        if (lane == 0) flags[buf * 8 + wid] = wdone ? 1u : 0u;
        __syncthreads();
        if (j == 0) break;
        unsigned nd = 0;
#pragma unroll
        for (int w = 0; w < 8; ++w) nd += flags[buf * 8 + w];
        if (nd == 8u) break;
    }
#undef SBA_LOAD
#undef SBA_STORE
    {
        const int erow = lane >> 4, ec = lane & 15;
        u32x4 sgv[8];
#pragma unroll
        for (int i = 0; i < 8; ++i) sgv[i] = *(const u32x4*)(SGb + (rowbase + tw0 + 4 * i + erow) * DM + h * HD + ec * 8);
        LAS unsigned char* stg = lds + wid * (32 * KP);
#pragma unroll
        for (int db = 0; db < 4; ++db)
#pragma unroll
            for (int r = 0; r < 16; r += 2) {
                const unsigned pk = cvtpk(o[db][r], o[db][r + 1]);
                *(LAS unsigned short*)(stg + crow(r, hi) * KP + (db * 32 + r32) * 2) = (unsigned short)(pk & 0xffffu);
                *(LAS unsigned short*)(stg + crow(r + 1, hi) * KP + (db * 32 + r32) * 2) = (unsigned short)(pk >> 16);
            }
        asm volatile("s_waitcnt lgkmcnt(0)" ::: "memory");
#pragma unroll
        for (int i = 0; i < 8; ++i) {
            const u32x4 ov = *(const LAS u32x4*)(stg + (4 * i + erow) * KP + ec * 16);
            u32x4 w;
#pragma unroll
            for (int j = 0; j < 4; ++j) w[j] = cvtpk(__uint_as_float(ov[j] << 16) * __uint_as_float(sgv[i][j] << 16), __uint_as_float(ov[j] & 0xffff0000u) * __uint_as_float(sgv[i][j] & 0xffff0000u));
            *(u32x4*)(OG + (rowbase + tw0 + 4 * i + erow) * DM + h * HD + ec * 8) = w;
        }
    }
    __syncthreads();
}
}

#ifndef MK_PH_LO
#define MK_PH_LO 0
#endif
#ifndef MK_PH_HI
#define MK_PH_HI 9
#endif
__global__ void __launch_bounds__(NWAVES * 64, 2) yoco_fwd(Params p) {
    extern __shared__ __attribute__((aligned(16))) unsigned char lds_raw[];
    LAS unsigned char* lds = (LAS unsigned char*)lds_raw;
    cg::grid_group grid = cg::this_grid();
    const int G = gridDim.x, bx = blockIdx.x;
    const int vcu = (G % 8 == 0) ? (bx % 8) * (G / 8) + bx / 8 : bx;
    unsigned char* ws = p.ws;
    bf16* W1T = (bf16*)(ws + WS_W1T); bf16* W2T = (bf16*)(ws + WS_W2T); bf16* W3T = (bf16*)(ws + WS_W3T); bf16* W4T = (bf16*)(ws + WS_W4T);

#ifndef PHMASK
#define PHMASK 0x1ff
#endif
#ifndef REPMASK
#define REPMASK 0
#endif
#define NREP(k) (((REPMASK) >> (k)) & 1 ? 2 : 1)
#define PH(k) for (int rep_ = 0; rep_ < NREP(k); ++rep_) if ((rep_ ? (grid.sync(), true) : true) && ((PHMASK >> (k)) & 1))
    PH(0) p0_phase(lds, p, G);
    grid.sync();
    PH(1) {
        pg8::Gemm g{(const bf16*)(ws + WS_XB), W1T, MROWS, 3 * AW, DM}; pg8::StaticOrder S; S.init(MROWS, 3 * AW, G, bx);
        pg8::EpiG1 E{(bf16*)(ws + WS_U), (size_t)(WS_GVT - WS_U) / 2, (float*)(ws + WS_ST), p.a_b_in};
        pg8::gemm_phase<pg8::EpiG1, pg8::StaticOrder, true, true>(lds, g, S, E);
    }
    grid.sync();
    PH(2) mix_phase(lds, p, bx, G);
    grid.sync();
    PH(3) {
        pg8::Gemm g{(const bf16*)(ws + WS_SM), W2T, MROWS, DM, AW}; pg8::StaticOrder S; S.init(MROWS, DM, G, bx);
        pg8::EpiRes E{p.x, (float*)(ws + WS_Z)};
        pg8::gemm_phase<pg8::EpiRes, pg8::StaticOrder, true, true>(lds, g, S, E);
    }
    grid.sync();
    PH(4) ln_phase((const float*)(ws + WS_Z), p.ln_g, p.ln_b, (float*)(ws + WS_X1), (bf16*)(ws + WS_X1B), G);
    grid.sync();
    PH(5) {
        pg8::Gemm g{(const bf16*)(ws + WS_X1B), W3T, MROWS, 4 * DM, DM}; pg8::StaticOrder S; S.init(MROWS, 4 * DM, G, bx);
        pg8::EpiG3 E{(bf16*)(ws + WS_KB), (size_t)(WS_VT - WS_KB) / 2};
        pg8::gemm_phase<pg8::EpiG3, pg8::StaticOrder, true, true>(lds, g, S, E);
    }
    grid.sync();
    PH(6) {
        for (int v = vcu; v < 256; v += G) {
            const int bh = v >> 3, s = v & 7;
            for (int i = 0; i < 2; ++i)
                sba::attn_unit(lds, bh >> 4, bh & 15, i == 0 ? 15 - s : s, (const bf16*)(ws + WS_QB), (const bf16*)(ws + WS_KB), (const bf16*)(ws + WS_VT), (const bf16*)(ws + WS_SGB), (bf16*)(ws + WS_OG));
        }
    }
    grid.sync();
    PH(7) {
        pg8::Gemm g{(const bf16*)(ws + WS_OG), W4T, MROWS, DM, DM}; pg8::StaticOrder S; S.init(MROWS, DM, G, bx);
        pg8::EpiRes E{(const float*)(ws + WS_X1), (float*)(ws + WS_Z2)};
        pg8::gemm_phase<pg8::EpiRes, pg8::StaticOrder, true, true>(lds, g, S, E);
    }
    grid.sync();
    PH(8) ln_phase((const float*)(ws + WS_Z2), p.ln_g + DM, p.ln_b + DM, p.out, nullptr, G);
}

extern "C" void kernel_launch(void* const* d_in, const int* in_sizes, int n_in, void* d_out, int out_size, void* d_ws, size_t ws_size, hipStream_t stream) {
    static int grid = 0;
    if (grid == 0) {
        if (n_in != 13 || in_sizes[0] != MROWS * DM || out_size != MROWS * DM || ws_size < WS_END) {
            fprintf(stderr, "kernel_launch: shape/workspace mismatch (n_in %d, in0 %d, out %d, ws %zu, need %zu)\n", n_in, n_in > 0 ? in_sizes[0] : -1, out_size, ws_size, (size_t)WS_END); grid = -1; return; }
        int dev = 0, cus = 0, per_cu = 0;
        hipGetDevice(&dev);
        hipDeviceGetAttribute(&cus, hipDeviceAttributeMultiprocessorCount, dev);
        if (hipFuncSetAttribute((const void*)yoco_fwd, hipFuncAttributeMaxDynamicSharedMemorySize, LDS_BYTES) != hipSuccess) { fprintf(stderr, "kernel_launch: hipFuncSetAttribute failed\n"); grid = -1; return; }
        if (hipOccupancyMaxActiveBlocksPerMultiprocessor(&per_cu, (const void*)yoco_fwd, NWAVES * 64, LDS_BYTES) != hipSuccess || per_cu < 1) { fprintf(stderr, "kernel_launch: occupancy query says %d\n", per_cu); per_cu = 1; }
        (void)hipGetLastError();
        grid = cus * (per_cu > 1 ? 1 : per_cu);
    }
    if (grid < 0) return;
    Params p{};
    p.x = (const float*)d_in[0]; p.a_w_in = (const float*)d_in[1]; p.a_b_in = (const float*)d_in[2]; p.a_vln_g = (const float*)d_in[3]; p.a_vln_b = (const float*)d_in[4];
    p.a_w_s = (const float*)d_in[5]; p.a_b_s = (const float*)d_in[6]; p.a_w_out = (const float*)d_in[7]; p.kv_w = (const float*)d_in[8]; p.b_w_in = (const float*)d_in[9];
    p.b_w_out = (const float*)d_in[10]; p.ln_g = (const float*)d_in[11]; p.ln_b = (const float*)d_in[12]; p.out = (float*)d_out; p.ws = (unsigned char*)d_ws;
    void* args[] = {&p};
    const hipError_t e = hipLaunchCooperativeKernel((const void*)yoco_fwd, dim3(grid), dim3(NWAVES * 64), args, LDS_BYTES, stream);
    if (e != hipSuccess) fprintf(stderr, "kernel_launch: cooperative launch failed: %s (grid %d)\n", hipGetErrorString(e), grid);
}
```

```cpp
#include <hip/hip_runtime.h>
#include <hip/hip_cooperative_groups.h>
#include <cstdio>
#include <cstdint>
namespace cg = cooperative_groups;
namespace pg8 {
#define PG8_LAS __attribute__((address_space(3)))
typedef unsigned short bf16_t;
typedef short bf16x8 __attribute__((ext_vector_type(8)));
typedef float f32x4 __attribute__((ext_vector_type(4)));
typedef unsigned u32x4 __attribute__((ext_vector_type(4)));
constexpr int BM = 256, BK = 64, HALF = 128, HTB = HALF * BK * 2  , STAGE_BYTES = 8 * HTB, NXCD = 8, WGM = 8;

__host__ __device__ __forceinline__ int lds_byte(int r, int c) { const int st = (r >> 4) * 2 + (c >> 5), rr = r & 15, cc = c & 31, ob = rr * 64 + cc * 2; return st * 1024 + (ob ^ (((ob >> 9) & 1) << 5)); }
__host__ __device__ __forceinline__ void stage_rc(int b, int& R, int& C) { const int st = b / 1024, sb = b % 1024, swz = sb ^ (((sb >> 9) & 1) << 5); R = (st >> 1) * 16 + swz / 64; C = (st & 1) * 32 + (swz % 64) / 2; }
__host__ __device__ __forceinline__ int perm32(int rho) { const int n = rho >> 4, i = rho & 15; return 8 * (i >> 2) + 4 * n + (i & 3); }

struct Unit { int pm, pn; };
struct Gemm { const bf16_t* A; const bf16_t* Bt; int M, N, K; };

struct StaticOrder {
    int nM, nN, nwg, G, c;
    __host__ __device__ void init(int M, int N, int G_, int c_) { nM = M / BM; nN = N / BM; nwg = nM * nN; G = G_; c = c_; }
    __host__ __device__ bool next(int i, Unit& u) const {
        const long L = (long)i * G + c; if (L >= nwg) return false;
        int wgid = (int)L; { const int q = nwg / NXCD, r = nwg % NXCD, xcd = wgid % NXCD, off = wgid / NXCD; wgid = (xcd < r ? xcd * (q + 1) : r * (q + 1) + (xcd - r) * q) + off; }
        const int nig = WGM * nN, gid = wgid / nig, fm = gid * WGM, gsz = (nM - fm) < WGM ? (nM - fm) : WGM;
        u.pm = fm + ((wgid % nig) % gsz); u.pn = (wgid % nig) / gsz; return true;
    }
    __device__ __forceinline__ void a_ready(const Unit&) const {}
    __device__ __forceinline__ void done(const Unit&) const {}
};

__device__ __forceinline__ unsigned cvt_pk_bf16(float lo, float hi) { unsigned r; asm volatile("v_cvt_pk_bf16_f32 %0, %1, %2" : "=v"(r) : "v"(lo), "v"(hi)); return r; }
typedef float f32x2 __attribute__((ext_vector_type(2)));
template <class Epi, class Sched, bool ALIGN_EPI = false, bool SP2 = false>
__device__ __forceinline__ void gemm_phase(PG8_LAS unsigned char* lds, const Gemm g, const Sched& S, const Epi& E) {
    int tid_ = threadIdx.x; asm volatile("" : "+v"(tid_));
    const int tid = tid_, wid = __builtin_amdgcn_readfirstlane(tid >> 6), lane = tid & 63, wr = wid >> 2, wc = wid & 3, fr = lane & 15, fq = lane >> 4;
    const int K = g.K, nt = K / BK;
    unsigned voffA[2], voffB[2];
#pragma unroll
    for (int i = 0; i < 2; ++i) { int R, C; stage_rc(tid * 16 + i * 8192, R, C); const int Rb = Epi::PERM ? ((R & ~31) + perm32(R & 31)) : R;
        voffA[i] = (unsigned)(R * K + C) * 2u; voffB[i] = (unsigned)(Rb * K + C) * 2u; }
    const size_t kstep = (size_t)(BK * 2);
    const size_t hstep = (size_t)HALF * K * 2;
    const size_t tstep = 2 * hstep;
    const unsigned ldsw = (unsigned)wid * 1024u;
    const int aoff = lds_byte(wr * 64 + fr, fq * 8), boff = lds_byte(wc * 32 + fr, fq * 8);
#define PG8_SA(b, h) (((b) * 2 + (h)) * HTB)
#define PG8_SB(b, h) ((4 + (b) * 2 + (h)) * HTB)
#define PG8_STAGE(bufoff, gbase, voff) do { _Pragma("unroll") for (int _i = 0; _i < 2; ++_i) \
        __builtin_amdgcn_global_load_lds((const unsigned*)((const char*)(gbase) + (voff)[_i]), (PG8_LAS unsigned*)(lds + (bufoff) + ldsw + _i * 8192), 16, 0, 0); } while (0)
#define PG8_LDA(dst, b, h) do { _Pragma("unroll") for (int m = 0; m < 4; ++m) _Pragma("unroll") for (int k = 0; k < 2; ++k) dst[m][k] = *(const PG8_LAS bf16x8*)(lds + PG8_SA(b, h) + aoff + m * 2048 + k * 1024); } while (0)
#define PG8_LDB(dst, b, h) do { _Pragma("unroll") for (int n = 0; n < 2; ++n) _Pragma("unroll") for (int k = 0; k < 2; ++k) dst[n][k] = *(const PG8_LAS bf16x8*)(lds + PG8_SB(b, h) + boff + n * 2048 + k * 1024); } while (0)
#define PG8_MMA(ai, bj, At, Bt) do { __builtin_amdgcn_s_setprio(1); _Pragma("unroll") for (int m = 0; m < 4; ++m) _Pragma("unroll") for (int n = 0; n < 2; ++n) _Pragma("unroll") for (int k = 0; k < 2; ++k) \
        acc[ai][bj][m][n] = __builtin_amdgcn_mfma_f32_16x16x32_bf16(Bt[n][k], At[m][k], acc[ai][bj][m][n], 0, 0, 0); __builtin_amdgcn_s_setprio(0); } while (0)
#define PG8_WAIT_V(n) asm volatile("s_waitcnt vmcnt(" #n ")" ::: "memory")
#define PG8_WAIT_L(n) asm volatile("s_waitcnt lgkmcnt(" #n ")" ::: "memory")
#define PG8_BAR __builtin_amdgcn_s_barrier()
#define PG8_SCHED __builtin_amdgcn_sched_barrier(0)
    Unit cur, nxt; int ui = 0;
    if (!S.next(0, cur)) return;
    f32x4 acc[2][2][4][2];
#pragma unroll
    for (int a = 0; a < 2; ++a)
#pragma unroll
        for (int b = 0; b < 2; ++b)
#pragma unroll
            for (int m = 0; m < 4; ++m)
#pragma unroll
                for (int n = 0; n < 2; ++n) acc[a][b][m][n] = (f32x4){0.f, 0.f, 0.f, 0.f};
    bf16x8 At[4][2], B0[2][2], B1[2][2];
    const char* cA = (const char*)g.A + (size_t)cur.pm * tstep; const char* cB = (const char*)g.Bt + (size_t)cur.pn * tstep;
    S.a_ready(cur);
    if constexpr (SP2) {
        PG8_STAGE(PG8_SB(0, 0), cB, voffB); PG8_STAGE(PG8_SB(0, 1), cB + hstep, voffB); PG8_STAGE(PG8_SA(0, 0), cA, voffA); PG8_STAGE(PG8_SA(0, 1), cA + hstep, voffA);
        if (wr == 1) PG8_BAR;
        PG8_WAIT_V(2); PG8_BAR;
        PG8_STAGE(PG8_SB(1, 0), cB + kstep, voffB); PG8_STAGE(PG8_SA(1, 0), cA + kstep, voffA); PG8_STAGE(PG8_SB(1, 1), cB + hstep + kstep, voffB);
        PG8_WAIT_V(6); PG8_BAR;
    } else {
        PG8_STAGE(PG8_SB(0, 0), cB, voffB); PG8_STAGE(PG8_SA(0, 0), cA, voffA); PG8_STAGE(PG8_SB(0, 1), cB + hstep, voffB); PG8_STAGE(PG8_SA(0, 1), cA + hstep, voffA);
        if (wr == 1) PG8_BAR;
        PG8_WAIT_V(4); PG8_BAR;
        PG8_STAGE(PG8_SB(1, 0), cB + kstep, voffB); PG8_STAGE(PG8_SA(1, 0), cA + kstep, voffA); PG8_STAGE(PG8_SB(1, 1), cB + hstep + kstep, voffB);
        PG8_WAIT_V(6); PG8_BAR;
    }
    for (;;) {
        const bool has_next = S.next(ui + 1, nxt);
        const char* nA = has_next ? (const char*)g.A + (size_t)nxt.pm * tstep : cA; const char* nB = has_next ? (const char*)g.Bt + (size_t)nxt.pn * tstep : cB;
        for (int t = 0; t < nt; t += 2) {
            const bool last = (t == nt - 2);
            const char* a1 = cA + (size_t)(t + 1) * kstep;
            const char* a2 = last ? nA : cA + (size_t)(t + 2) * kstep; const char* b2 = last ? nB : cB + (size_t)(t + 2) * kstep;
            const char* a3 = a2 + kstep; const char* b3 = b2 + kstep;
            if (last && has_next) S.a_ready(nxt);
            if constexpr (SP2) {
            PG8_LDB(B0, 0, 0); PG8_LDB(B1, 0, 1); PG8_SCHED; PG8_LDA(At, 0, 0); PG8_STAGE(PG8_SA(1, 1), a1 + hstep, voffA);
            PG8_WAIT_V(8); PG8_WAIT_L(0); PG8_BAR; PG8_MMA(0, 0, At, B0); PG8_MMA(0, 1, At, B1); PG8_BAR; PG8_SCHED;
            PG8_LDA(At, 0, 1); PG8_STAGE(PG8_SB(0, 0), b2, voffB); PG8_STAGE(PG8_SB(0, 1), b2 + hstep, voffB); PG8_STAGE(PG8_SA(0, 0), a2, voffA);
            PG8_WAIT_V(8); PG8_WAIT_L(0); PG8_BAR; PG8_MMA(1, 0, At, B0); PG8_MMA(1, 1, At, B1); PG8_BAR; PG8_SCHED;
            PG8_LDB(B0, 1, 0); PG8_LDB(B1, 1, 1); PG8_SCHED; PG8_LDA(At, 1, 0); PG8_STAGE(PG8_SA(0, 1), a2 + hstep, voffA);
            PG8_WAIT_V(8); PG8_WAIT_L(0); PG8_BAR; PG8_MMA(0, 0, At, B0); PG8_MMA(0, 1, At, B1); PG8_BAR; PG8_SCHED;
            PG8_LDA(At, 1, 1); PG8_STAGE(PG8_SB(1, 0), b3, voffB); PG8_STAGE(PG8_SB(1, 1), b3 + hstep, voffB); PG8_STAGE(PG8_SA(1, 0), a3, voffA);
            PG8_WAIT_V(8); PG8_WAIT_L(0); PG8_BAR; PG8_MMA(1, 0, At, B0); PG8_MMA(1, 1, At, B1); PG8_BAR; PG8_SCHED;
            } else {
            PG8_LDB(B0, 0, 0); PG8_SCHED; PG8_LDA(At, 0, 0); PG8_STAGE(PG8_SA(1, 1), a1 + hstep, voffA);
            PG8_WAIT_L(8); PG8_BAR; PG8_WAIT_L(0); PG8_MMA(0, 0, At, B0); PG8_BAR; PG8_SCHED;
            PG8_LDB(B1, 0, 1); PG8_STAGE(PG8_SB(0, 0), b2, voffB);
            PG8_BAR; PG8_WAIT_L(0); PG8_MMA(0, 1, At, B1); PG8_BAR;
            PG8_LDA(At, 0, 1); PG8_STAGE(PG8_SA(0, 0), a2, voffA);
            PG8_BAR; PG8_WAIT_L(0); PG8_MMA(1, 0, At, B0); PG8_BAR; PG8_SCHED;
            PG8_STAGE(PG8_SB(0, 1), b2 + hstep, voffB);
            PG8_WAIT_V(6); PG8_BAR; PG8_MMA(1, 1, At, B1); PG8_BAR;
            PG8_LDB(B0, 1, 0); PG8_SCHED; PG8_LDA(At, 1, 0); PG8_STAGE(PG8_SA(0, 1), a2 + hstep, voffA);
            PG8_WAIT_L(8); PG8_BAR; PG8_WAIT_L(0); PG8_MMA(0, 0, At, B0); PG8_BAR; PG8_SCHED;
            PG8_LDB(B1, 1, 1); PG8_STAGE(PG8_SB(1, 0), b3, voffB);
            PG8_BAR; PG8_WAIT_L(0); PG8_MMA(0, 1, At, B1); PG8_BAR;
            PG8_LDA(At, 1, 1); PG8_STAGE(PG8_SA(1, 0), a3, voffA);
            PG8_BAR; PG8_WAIT_L(0); PG8_MMA(1, 0, At, B0); PG8_BAR; PG8_SCHED;
            PG8_STAGE(PG8_SB(1, 1), b3 + hstep, voffB);
            PG8_WAIT_V(6); PG8_BAR; PG8_MMA(1, 1, At, B1); PG8_BAR;
            }
        }
        if constexpr (ALIGN_EPI) { if (wr == 0) PG8_BAR; }
        if constexpr (!Epi::AFTER_DRAIN) { E(acc, cur, wr, wc, fr, fq); S.done(cur); }
        if (!has_next) break;
#pragma unroll
        for (int a = 0; a < 2; ++a)
#pragma unroll
            for (int b = 0; b < 2; ++b)
#pragma unroll
                for (int m = 0; m < 4; ++m)
#pragma unroll
                    for (int n = 0; n < 2; ++n) acc[a][b][m][n] = (f32x4){0.f, 0.f, 0.f, 0.f};
        cur = nxt; cA = nA; cB = nB; ++ui;
        if constexpr (ALIGN_EPI) { if (wr == 1) PG8_BAR; }
    }
    PG8_WAIT_V(0);
    if constexpr (!ALIGN_EPI) { if (wr == 0) PG8_BAR; }
    PG8_BAR;
    if constexpr (Epi::AFTER_DRAIN) { E.fused(acc, cur, wr, wc, fr, fq, lds, wid, lane); S.done(cur); }
#undef PG8_SA
#undef PG8_SB
#undef PG8_STAGE
#undef PG8_LDA
#undef PG8_LDB
#undef PG8_MMA
#undef PG8_WAIT_V
#undef PG8_WAIT_L
#undef PG8_BAR
#undef PG8_SCHED
}
}

constexpr int DM = 2048, SEQ = 4096, NB = 2, MROWS = NB * SEQ;
constexpr int AW = 4096, NG = 8, GD = 512, CH = 128;
constexpr int NH = 16, HD = 128;
constexpr float LN_EPS = 1e-5f;
constexpr float DN_ALPHA = 1.4142135623730951f;
constexpr float QSCALE = 0.08838834764831845f * 1.4426950408889634f;

#define LAS __attribute__((address_space(3)))
typedef unsigned short bf16;
typedef float f32x4 __attribute__((ext_vector_type(4)));
typedef float f32x2 __attribute__((ext_vector_type(2)));
typedef float f32x16 __attribute__((ext_vector_type(16)));
typedef short bf16x8 __attribute__((ext_vector_type(8)));
typedef short s16x4 __attribute__((ext_vector_type(4)));
typedef unsigned u32x4 __attribute__((ext_vector_type(4)));
typedef unsigned u32x2 __attribute__((ext_vector_type(2)));

__device__ __forceinline__ int opaque_tid() { int t = threadIdx.x; asm volatile("" : "+v"(t)); return t; }
__device__ __forceinline__ unsigned cvtpk(float lo, float hi) { unsigned r; asm volatile("v_cvt_pk_bf16_f32 %0, %1, %2" : "=v"(r) : "v"(lo), "v"(hi)); return r; }
__device__ __forceinline__ float bf2f(unsigned short b) { return __uint_as_float(((unsigned)b) << 16); }
__device__ __forceinline__ float gelu_tanh(float x) { const float t = x * (1.f + 0.044715f * x * x) * 2.302208198f; return x * __builtin_amdgcn_rcpf(1.f + __builtin_amdgcn_exp2f(-t)); }
__device__ __forceinline__ float silu_f(float x) { return x * __builtin_amdgcn_rcpf(1.f + __builtin_amdgcn_exp2f(-1.4426950408889634f * x)); }

namespace pg8 {
__device__ __forceinline__ f32x4 gelu4(f32x4 v) { return (f32x4){gelu_tanh(v[0]), gelu_tanh(v[1]), gelu_tanh(v[2]), gelu_tanh(v[3])}; }
__device__ __forceinline__ f32x4 silu4(f32x4 v) { return (f32x4){silu_f(v[0]), silu_f(v[1]), silu_f(v[2]), silu_f(v[3])}; }
struct EpiG1 {
    static constexpr bool PERM = true, AFTER_DRAIN = false;
    bf16_t* base; size_t rstride; float* stats; const float* bias;
    __device__ __forceinline__ void operator()(const f32x4 (&acc)[2][2][4][2], const Unit& u, int wr, int wc, int fr, int fq) const {
        const int region = u.pn >> 4, pnr = u.pn & 15;
        const int col0 = pnr * BM + wc * 32 + 8 * fq, bcol0 = u.pn * BM + wc * 32 + 8 * fq;
        f32x4 bv[2][2];
#pragma unroll
        for (int bj = 0; bj < 2; ++bj)
#pragma unroll
            for (int n = 0; n < 2; ++n) bv[bj][n] = *(const f32x4*)(bias + bcol0 + bj * HALF + 4 * n);
#pragma unroll
        for (int ai = 0; ai < 2; ++ai)
#pragma unroll
            for (int m = 0; m < 4; ++m) {
                const int row = u.pm * BM + ai * HALF + wr * 64 + m * 16 + fr;
                float s = 0.f, ss = 0.f;
#pragma unroll
                for (int bj = 0; bj < 2; ++bj) {
                    f32x4 a0 = acc[ai][bj][m][0] + bv[bj][0], a1 = acc[ai][bj][m][1] + bv[bj][1];
                    if (region == 2) { a0 = silu4(a0); a1 = silu4(a1); } else { a0 = gelu4(a0); a1 = gelu4(a1); }
                    u32x4 w; w.x = cvtpk(a0[0], a0[1]); w.y = cvtpk(a0[2], a0[3]); w.z = cvtpk(a1[0], a1[1]); w.w = cvtpk(a1[2], a1[3]);
                    if (region == 1) {
                        s += ((a0[0] + a0[1]) + (a0[2] + a0[3])) + ((a1[0] + a1[1]) + (a1[2] + a1[3]));
                        ss += ((a0[0] * a0[0] + a0[1] * a0[1]) + (a0[2] * a0[2] + a0[3] * a0[3])) + ((a1[0] * a1[0] + a1[1] * a1[1]) + (a1[2] * a1[2] + a1[3] * a1[3]));
                        bf16_t* tp = base + rstride + ((size_t)(row >> 7) * AW + col0 + bj * HALF) * CH + (row & 127);
                        tp[0 * CH] = (bf16_t)(w.x & 0xffffu); tp[1 * CH] = (bf16_t)(w.x >> 16); tp[2 * CH] = (bf16_t)(w.y & 0xffffu); tp[3 * CH] = (bf16_t)(w.y >> 16);
                        tp[4 * CH] = (bf16_t)(w.z & 0xffffu); tp[5 * CH] = (bf16_t)(w.z >> 16); tp[6 * CH] = (bf16_t)(w.w & 0xffffu); tp[7 * CH] = (bf16_t)(w.w >> 16);
                    } else {
                        bf16_t* dst = base + (size_t)region * rstride + (size_t)row * AW + col0 + bj * HALF;
                        *(u32x4*)dst = w;
                    }
                }
                if (region == 1) {
                    s += __shfl_xor(s, 16); s += __shfl_xor(s, 32); ss += __shfl_xor(ss, 16); ss += __shfl_xor(ss, 32);
                    if (fq == 0) *(f32x2*)(stats + ((size_t)row * 64 + pnr * 4 + wc) * 2) = (f32x2){s, ss};
                }
            }
    }
};
struct EpiG3 {
    static constexpr bool PERM = true, AFTER_DRAIN = false;
    bf16_t* base; size_t rstride;
    __device__ __forceinline__ void operator()(const f32x4 (&acc)[2][2][4][2], const Unit& u, int wr, int wc, int fr, int fq) const {
        const int region = u.pn >> 3, pnr = u.pn & 7;
        const int col0 = pnr * BM + wc * 32 + 8 * fq;
#pragma unroll
        for (int ai = 0; ai < 2; ++ai)
#pragma unroll
            for (int m = 0; m < 4; ++m) {
                const int row = u.pm * BM + ai * HALF + wr * 64 + m * 16 + fr;
#pragma unroll
                for (int bj = 0; bj < 2; ++bj) {
                    f32x4 a0 = acc[ai][bj][m][0], a1 = acc[ai][bj][m][1];
                    if (region == 3) { a0 = silu4(a0); a1 = silu4(a1); } else if (region == 2) { a0 = a0 * QSCALE; a1 = a1 * QSCALE; }
                    u32x4 w; w.x = cvtpk(a0[0], a0[1]); w.y = cvtpk(a0[2], a0[3]); w.z = cvtpk(a1[0], a1[1]); w.w = cvtpk(a1[2], a1[3]);
                    if (region == 1) {
                        bf16_t* tp = base + rstride + ((size_t)(row >> 12) * DM + col0 + bj * HALF) * SEQ + (row & (SEQ - 1));
                        tp[0 * SEQ] = (bf16_t)(w.x & 0xffffu); tp[1 * SEQ] = (bf16_t)(w.x >> 16); tp[2 * SEQ] = (bf16_t)(w.y & 0xffffu); tp[3 * SEQ] = (bf16_t)(w.y >> 16);
                        tp[4 * SEQ] = (bf16_t)(w.z & 0xffffu); tp[5 * SEQ] = (bf16_t)(w.z >> 16); tp[6 * SEQ] = (bf16_t)(w.w & 0xffffu); tp[7 * SEQ] = (bf16_t)(w.w >> 16);
                    } else {
                        bf16_t* dst = base + (size_t)region * rstride + (size_t)row * DM + col0 + bj * HALF;
                        *(u32x4*)dst = w;
                    }
                }
            }
    }
};
struct EpiRes {
    static constexpr bool PERM = false, AFTER_DRAIN = false;
    const float* X; float* Z;
    __device__ __forceinline__ void operator()(const f32x4 (&acc)[2][2][4][2], const Unit& u, int wr, int wc, int fr, int fq) const {
        const int col0 = u.pn * BM + wc * 32 + 4 * fq;
#pragma unroll
        for (int ai = 0; ai < 2; ++ai)
#pragma unroll
            for (int m = 0; m < 4; ++m) {
                const size_t off = (size_t)(u.pm * BM + ai * HALF + wr * 64 + m * 16 + fr) * DM + col0;
#pragma unroll
                for (int bj = 0; bj < 2; ++bj)
#pragma unroll
                    for (int n = 0; n < 2; ++n) { const f32x4 xv = *(const f32x4*)(X + off + bj * HALF + n * 16); *(f32x4*)(Z + off + bj * HALF + n * 16) = xv * DN_ALPHA + acc[ai][bj][m][n]; }
            }
    }
};
}

constexpr size_t MiB = 1u << 20;
constexpr size_t WS_W2T = 0 * MiB;
constexpr size_t WS_W3T = 16 * MiB;
constexpr size_t WS_W4T = 48 * MiB;
constexpr size_t WS_W1T = 56 * MiB;
constexpr size_t WS_XB  = 104 * MiB;
constexpr size_t WS_SM  = 56 * MiB;
constexpr size_t WS_U   = 136 * MiB;
constexpr size_t WS_GVT = 200 * MiB;
constexpr size_t WS_SG  = 264 * MiB;
constexpr size_t WS_ST  = 328 * MiB;
constexpr size_t WS_Z   = 136 * MiB;
constexpr size_t WS_X1  = 200 * MiB;
constexpr size_t WS_X1B = 264 * MiB;
constexpr size_t WS_KB  = 56 * MiB;
constexpr size_t WS_VT  = 88 * MiB;
constexpr size_t WS_QB  = 120 * MiB;
constexpr size_t WS_SGB = 152 * MiB;
constexpr size_t WS_OG  = 296 * MiB;
constexpr size_t WS_Z2  = 56 * MiB;
constexpr size_t WS_END = 332 * MiB;
static_assert(WS_SG - WS_GVT == WS_GVT - WS_U && WS_VT - WS_KB == WS_QB - WS_VT && WS_SGB - WS_QB == WS_VT - WS_KB, "region strides");

constexpr int LDS_BYTES = 147456;
constexpr int NWAVES = 8;

struct Params {
    const float* x; const float* a_w_in; const float* a_b_in; const float* a_vln_g; const float* a_vln_b; const float* a_w_s; const float* a_b_s; const float* a_w_out;
    const float* kv_w; const float* b_w_in; const float* b_w_out; const float* ln_g; const float* ln_b;
    float* out; unsigned char* ws;
};

__device__ __forceinline__ void p0_transpose_item(const float* W, int K, int N, bf16* WT, int row_off, LAS float* scr, int item, int lane) {
    const int nblk = N / 64, kb = item / nblk, nb = item % nblk, k0 = 64 * kb, n0 = 64 * nb;
    const int lr = lane >> 4, lc = (lane & 15) * 4;
    f32x4 v[16];
#pragma unroll
    for (int i = 0; i < 16; ++i) v[i] = __builtin_nontemporal_load((const f32x4*)(W + (size_t)(k0 + 4 * i + lr) * N + n0 + lc));
#pragma unroll
    for (int i = 0; i < 16; ++i) { LAS float* d = scr + (4 * i + lr) * 65 + lc; d[0] = v[i][0]; d[1] = v[i][1]; d[2] = v[i][2]; d[3] = v[i][3]; }
    asm volatile("s_waitcnt lgkmcnt(0)" ::: "memory");
    const int c = lane & 7;
#pragma unroll
    for (int j = 0; j < 8; ++j) { const int n = (lane >> 3) + 8 * j; const LAS float* s = scr + (8 * c) * 65 + n;
        u32x4 o; o.x = cvtpk(s[0 * 65], s[1 * 65]); o.y = cvtpk(s[2 * 65], s[3 * 65]); o.z = cvtpk(s[4 * 65], s[5 * 65]); o.w = cvtpk(s[6 * 65], s[7 * 65]);
        *(u32x4*)(WT + (size_t)(row_off + n0 + n) * K + k0 + 8 * c) = o; }
    asm volatile("s_waitcnt lgkmcnt(0)" ::: "memory");
}
__device__ __forceinline__ void p0_phase(LAS unsigned char* lds, const Params& p, int G) {
    const int tid = opaque_tid(), lane = tid & 63, wave = tid >> 6;
    LAS float* scr = (LAS float*)(lds + wave * 16640);
    const int gw = blockIdx.x * NWAVES + wave, NGW = G * NWAVES;
    constexpr int I_1 = (DM / 64) * (3 * AW / 64), I_2 = (AW / 64) * (DM / 64), I_KV = (DM / 64) * (2 * DM / 64), I_BI = I_KV, I_BO = (DM / 64) * (DM / 64);
    constexpr int NITEMS = I_1 + I_2 + I_KV + I_BI + I_BO;
    bf16* W1T = (bf16*)(p.ws + WS_W1T); bf16* W2T = (bf16*)(p.ws + WS_W2T); bf16* W3T = (bf16*)(p.ws + WS_W3T); bf16* W4T = (bf16*)(p.ws + WS_W4T);
    for (int it = gw; it < NITEMS; it += NGW) {
        int r = it;
        if (r < I_1) { p0_transpose_item(p.a_w_in, DM, 3 * AW, W1T, 0, scr, r, lane); continue; } r -= I_1;
        if (r < I_2) { p0_transpose_item(p.a_w_out, AW, DM, W2T, 0, scr, r, lane); continue; } r -= I_2;
        if (r < I_KV) { p0_transpose_item(p.kv_w, DM, 2 * DM, W3T, 0, scr, r, lane); continue; } r -= I_KV;
        if (r < I_BI) { p0_transpose_item(p.b_w_in, DM, 2 * DM, W3T, 2 * DM, scr, r, lane); continue; } r -= I_BI;
        p0_transpose_item(p.b_w_out, DM, DM, W4T, 0, scr, r, lane);
    }
    bf16* XB = (bf16*)(p.ws + WS_XB);
    const size_t n8 = (size_t)MROWS * DM / 8, step = (size_t)G * 512;
    for (size_t i0 = (size_t)blockIdx.x * 512 + tid; i0 < n8; i0 += 4 * step) {
        f32x4 a[4], b[4];
#pragma unroll
        for (int k = 0; k < 4; ++k) { const size_t i = i0 + k * step; if (i < n8) { a[k] = __builtin_nontemporal_load((const f32x4*)(p.x + i * 8)); b[k] = __builtin_nontemporal_load((const f32x4*)(p.x + i * 8 + 4)); } }
#pragma unroll
        for (int k = 0; k < 4; ++k) { const size_t i = i0 + k * step; if (i < n8) {
            u32x4 o; o.x = cvtpk(a[k][0], a[k][1]); o.y = cvtpk(a[k][2], a[k][3]); o.z = cvtpk(b[k][0], b[k][1]); o.w = cvtpk(b[k][2], b[k][3]);
            *(u32x4*)(XB + i * 8) = o; } }
    }
}

__device__ __forceinline__ void mix_phase(LAS unsigned char* lds, const Params& p, int job_lo, int job_step) {
    constexpr int TP = 272;
    constexpr int OFF_A = 0, OFF_B = 128 * TP, OFF_MU = 2 * 128 * TP, OFF_RS = OFF_MU + 512, OFF_C1 = OFF_RS + 512, OFF_C2 = OFF_C1 + 512;
    const int tid = opaque_tid(), lane = tid & 63, wid = tid >> 6, wr = wid >> 2, wc = wid & 3, fr = lane & 15, fq = lane >> 4;
    const bf16* U = (const bf16*)(p.ws + WS_U); const bf16* GVt = (const bf16*)(p.ws + WS_GVT); const bf16* SG = (const bf16*)(p.ws + WS_SG);
    const float* stats = (const float*)(p.ws + WS_ST); bf16* SM = (bf16*)(p.ws + WS_SM);
    LAS float* mu = (LAS float*)(lds + OFF_MU); LAS float* rs = (LAS float*)(lds + OFF_RS); LAS float* c1s = (LAS float*)(lds + OFF_C1); LAS float* c2s = (LAS float*)(lds + OFF_C2);
    for (int job = job_lo; job < 256; job += job_step) {
        const int chunk = job >> 2, part = job & 3;
        __syncthreads();
        {
            const int row = tid >> 2, q = tid & 3;
            const f32x2* sp = (const f32x2*)stats + ((size_t)(chunk * CH + row) * 64 + q * 16);
            float s = 0.f, ss = 0.f;
#pragma unroll
            for (int i = 0; i < 16; ++i) { const f32x2 v = sp[i]; s += v.x; ss += v.y; }
            s += __shfl_xor(s, 1); s += __shfl_xor(s, 2); ss += __shfl_xor(ss, 1); ss += __shfl_xor(ss, 2);
            const float mean = s * (1.f / AW), var = ss * (1.f / AW) - mean * mean;
            if (q == 0) { mu[row] = mean; rs[row] = 1.0f / sqrtf(var + LN_EPS); }
        }
        __syncthreads();
        u32x4 nb[4], nu[4], ns[4], cu[4], cs[4];
#define MIX_PREFETCH(jj_) do { const int g_ = part * 2 + ((jj_) >> 2), ecol_ = g_ * GD + ((jj_) & 3) * 128; \
            const bf16* src_ = GVt + ((size_t)chunk * AW + ecol_ + (tid >> 2)) * CH + (tid & 3) * 32; \
            nb[0] = *(const u32x4*)(src_); nb[1] = *(const u32x4*)(src_ + 8); nb[2] = *(const u32x4*)(src_ + 16); nb[3] = *(const u32x4*)(src_ + 24); \
            _Pragma("unroll") for (int m_ = 0; m_ < 4; ++m_) { const size_t off_ = (size_t)(chunk * CH + wr * 64 + m_ * 16 + fr) * AW + ecol_ + wc * 32 + 8 * fq; nu[m_] = *(const u32x4*)(U + off_); ns[m_] = *(const u32x4*)(SG + off_); } } while (0)
        MIX_PREFETCH(0);
        for (int jj = 0; jj < 8; ++jj) {
            const int g = part * 2 + (jj >> 2), ecol0 = g * GD + (jj & 3) * 128;
            if ((jj & 3) == 0) {
                __syncthreads();
                const int t = tid >> 2, q = tid & 3;
                const float* wrow = p.a_w_s + ((size_t)g * CH + t) * CH + q * 32;
                float c1 = 0.f, c2 = 0.f;
#pragma unroll
                for (int i = 0; i < 4; ++i) {
                    const f32x4 w0 = *(const f32x4*)(wrow + i * 8), w1 = *(const f32x4*)(wrow + i * 8 + 4);
                    float w[8] = {w0[0], w0[1], w0[2], w0[3], w1[0], w1[1], w1[2], w1[3]};
                    float wp[8];
#pragma unroll
                    for (int j = 0; j < 8; ++j) { const int s = q * 32 + i * 8 + j; const float wm = (s <= t) ? w[j] : 0.f; c2 += wm; wp[j] = wm * rs[s]; }
                    u32x4 o; o.x = cvtpk(wp[0], wp[1]); o.y = cvtpk(wp[2], wp[3]); o.z = cvtpk(wp[4], wp[5]); o.w = cvtpk(wp[6], wp[7]);
#pragma unroll
                    for (int j = 0; j < 4; ++j) { const unsigned pk = o[j]; const int s = q * 32 + i * 8 + 2 * j; c1 += __uint_as_float(pk << 16) * mu[s] + __uint_as_float(pk & 0xffff0000u) * mu[s + 1]; }
                    *(LAS u32x4*)(lds + OFF_A + t * TP + (q * 32 + i * 8) * 2) = o;
                }
                c1 += __shfl_xor(c1, 1); c1 += __shfl_xor(c1, 2); c2 += __shfl_xor(c2, 1); c2 += __shfl_xor(c2, 2);
                if (q == 0) { c1s[t] = c1; c2s[t] = c2; }
            }
            __syncthreads();
            {
                LAS unsigned char* d = lds + OFF_B + (tid >> 2) * TP + (tid & 3) * 64;
                *(LAS u32x4*)(d) = nb[0]; *(LAS u32x4*)(d + 16) = nb[1]; *(LAS u32x4*)(d + 32) = nb[2]; *(LAS u32x4*)(d + 48) = nb[3];
#pragma unroll
                for (int m = 0; m < 4; ++m) { cu[m] = nu[m]; cs[m] = ns[m]; }
            }
            __syncthreads();
            if (jj < 7) MIX_PREFETCH(jj + 1);
            f32x4 acc[4][2];
#pragma unroll
            for (int m = 0; m < 4; ++m)
#pragma unroll
                for (int n = 0; n < 2; ++n) acc[m][n] = (f32x4){0.f, 0.f, 0.f, 0.f};
#pragma unroll
            for (int k = 0; k < 4; ++k) {
                bf16x8 af[4], bfr[2];
#pragma unroll
                for (int m = 0; m < 4; ++m) af[m] = *(const LAS bf16x8*)(lds + OFF_A + (wr * 64 + m * 16 + fr) * TP + (k * 32 + fq * 8) * 2);
#pragma unroll
                for (int n = 0; n < 2; ++n) { const int erow = wc * 32 + 8 * (fr >> 2) + 4 * n + (fr & 3); bfr[n] = *(const LAS bf16x8*)(lds + OFF_B + erow * TP + (k * 32 + fq * 8) * 2); }
#pragma unroll
                for (int m = 0; m < 4; ++m)
#pragma unroll
                    for (int n = 0; n < 2; ++n) acc[m][n] = __builtin_amdgcn_mfma_f32_16x16x32_bf16(bfr[n], af[m], acc[m][n], 0, 0, 0);
            }
            const int ec = ecol0 + wc * 32 + 8 * fq;
            const f32x4 g0 = *(const f32x4*)(p.a_vln_g + ec), g1 = *(const f32x4*)(p.a_vln_g + ec + 4), be0 = *(const f32x4*)(p.a_vln_b + ec), be1 = *(const f32x4*)(p.a_vln_b + ec + 4);
#pragma unroll
            for (int m = 0; m < 4; ++m) {
                const int t = wr * 64 + m * 16 + fr; const size_t off = (size_t)(chunk * CH + t) * AW + ec;
                const float c1 = c1s[t], c2 = c2s[t], bs = p.a_b_s[g * CH + t];
                const u32x4 uu = cu[m], sg = cs[m];
                const f32x4 m0 = g0 * (acc[m][0] - c1) + be0 * c2 + bs, m1 = g1 * (acc[m][1] - c1) + be1 * c2 + bs;
                u32x4 o;
                o.x = cvtpk(__uint_as_float(uu[0] << 16) * m0[0] * __uint_as_float(sg[0] << 16), __uint_as_float(uu[0] & 0xffff0000u) * m0[1] * __uint_as_float(sg[0] & 0xffff0000u));
                o.y = cvtpk(__uint_as_float(uu[1] << 16) * m0[2] * __uint_as_float(sg[1] << 16), __uint_as_float(uu[1] & 0xffff0000u) * m0[3] * __uint_as_float(sg[1] & 0xffff0000u));
                o.z = cvtpk(__uint_as_float(uu[2] << 16) * m1[0] * __uint_as_float(sg[2] << 16), __uint_as_float(uu[2] & 0xffff0000u) * m1[1] * __uint_as_float(sg[2] & 0xffff0000u));
                o.w = cvtpk(__uint_as_float(uu[3] << 16) * m1[2] * __uint_as_float(sg[3] << 16), __uint_as_float(uu[3] & 0xffff0000u) * m1[3] * __uint_as_float(sg[3] & 0xffff0000u));
                *(u32x4*)(SM + off) = o;
            }
        }
#undef MIX_PREFETCH
    }
}

__device__ __forceinline__ void ln_phase(const float* Z, const float* gam, const float* bet, float* Xout, bf16* Xb, int G) {
    const int tid = opaque_tid(), lane = tid & 63, wave = tid >> 6;
    f32x4 gv[8], bv[8];
#pragma unroll
    for (int j = 0; j < 8; ++j) { gv[j] = *(const f32x4*)(gam + (64 * j + lane) * 4); bv[j] = *(const f32x4*)(bet + (64 * j + lane) * 4); }
    for (int row = blockIdx.x * NWAVES + wave; row < MROWS; row += G * NWAVES) {
        const f32x4* zr = (const f32x4*)(Z + (size_t)row * DM) + lane;
        f32x4 v[8]; float s = 0.f;
#pragma unroll
        for (int j = 0; j < 8; ++j) { v[j] = zr[64 * j]; s += (v[j][0] + v[j][1]) + (v[j][2] + v[j][3]); }
#pragma unroll
        for (int o = 1; o < 64; o <<= 1) s += __shfl_xor(s, o);
        const float mean = s * (1.f / DM); float s2 = 0.f;
#pragma unroll
        for (int j = 0; j < 8; ++j) { v[j] = v[j] - mean; s2 += (v[j][0] * v[j][0] + v[j][1] * v[j][1]) + (v[j][2] * v[j][2] + v[j][3] * v[j][3]); }
#pragma unroll
        for (int o = 1; o < 64; o <<= 1) s2 += __shfl_xor(s2, o);
        const float rstd = 1.0f / sqrtf(s2 * (1.f / DM) + LN_EPS);
#pragma unroll
        for (int j = 0; j < 8; ++j) {
            const f32x4 y = v[j] * rstd * gv[j] + bv[j];
            *((f32x4*)(Xout + (size_t)row * DM) + 64 * j + lane) = y;
            if (Xb) { u32x2 w; w.x = cvtpk(y[0], y[1]); w.y = cvtpk(y[2], y[3]); *((u32x2*)(Xb + (size_t)row * DM) + 64 * j + lane) = w; }
        }
    }
}

namespace sba {
constexpr int KP = 272, VP = 136;
constexpr int KSB = 64 * KP, VSB = 128 * VP;
constexpr int OFF_K = 0, OFF_V = 2 * KSB, OFF_FLAG = 2 * KSB + 2 * VSB;
#ifndef SBA_EARLY_EXIT
#define SBA_EARLY_EXIT 1
#endif
__device__ __forceinline__ int crow(int r, int hi) { return (r & 3) + 8 * (r >> 2) + 4 * hi; }
__device__ __forceinline__ void sb_block(f32x16& p, float& c, int kbase, int trow, int hi, bool band) {
    float sfx[16];
#pragma unroll
    for (int r = 0; r < 16; ++r) {
        float e = __builtin_amdgcn_exp2f(__builtin_fminf(p[r], 100.f));
        if (band) { const int key = kbase + crow(r, hi); e = (key < trow) ? e : 0.f; }
        p[r] = e; sfx[r] = 1.f + e;
    }
    float lo[4], hh[4];
#pragma unroll
    for (int k = 0; k < 4; ++k) {
        sfx[4 * k + 2] *= sfx[4 * k + 3]; sfx[4 * k + 1] *= sfx[4 * k + 2]; sfx[4 * k] *= sfx[4 * k + 1];
        const unsigned tb = __float_as_uint(sfx[4 * k]);
        auto rr = __builtin_amdgcn_permlane32_swap(tb, tb, false, false);
        lo[k] = __uint_as_float(rr[0]); hh[k] = __uint_as_float(rr[1]);
    }
    float E[4];
#pragma unroll
    for (int k = 3; k >= 0; --k) { const float eh = c; c *= hh[k]; const float el = c; c *= lo[k]; E[k] = hi ? eh : el; }
#pragma unroll
    for (int r = 0; r < 16; ++r) p[r] = p[r] * __builtin_amdgcn_rcpf(sfx[r] * E[r >> 2]);
}
__device__ __forceinline__ void attn_unit(LAS unsigned char* lds, int b, int h, int qb, const bf16* Qb, const bf16* Kb, const bf16* Vt, const bf16* SGb, bf16* OG) {
    const int tid = opaque_tid(), lane = tid & 63, r32 = lane & 31, hi = lane >> 5;
    const int wid = __builtin_amdgcn_readfirstlane(tid >> 6);
    const int t0 = qb * 256, tw0 = t0 + wid * 32, trow = tw0 + r32;
    const size_t rowbase = (size_t)b * SEQ;
    bf16x8 qr[8];
    { const bf16* qp = Qb + (rowbase + trow) * DM + h * HD + hi * 8;
#pragma unroll
      for (int d0 = 0; d0 < 8; ++d0) qr[d0] = *(const bf16x8*)(qp + d0 * 16); }
    f32x16 o[4];
#pragma unroll
    for (int i = 0; i < 4; ++i)
#pragma unroll
        for (int r = 0; r < 16; ++r) o[i][r] = 0.f;
    float R = 1.f;
    const int krow = tid >> 3, kpc = tid & 7, vrow = tid >> 2, vpc = tid & 3;
    const bf16* kg = Kb + (rowbase + krow) * DM + h * HD + kpc * 16;
    const bf16* vg = Vt + ((size_t)(b * NH + h) * HD + vrow) * SEQ + vpc * 16;
    LAS unsigned char* kdst = lds + OFF_K + krow * KP + kpc * 32;
    LAS unsigned char* vdst = lds + OFF_V + vrow * VP + vpc * 32;
    LAS unsigned* flags = (LAS unsigned*)(lds + OFF_FLAG);
    const int jmax = 4 * qb + 3;
    u32x4 kr0, kr1, vr0, vr1;
#define SBA_LOAD(j) do { const bf16* kp_ = kg + (size_t)(j) * 64 * DM; kr0 = *(const u32x4*)kp_; kr1 = *(const u32x4*)(kp_ + 8); const bf16* vp_ = vg + (j) * 64; vr0 = *(const u32x4*)vp_; vr1 = *(const u32x4*)(vp_ + 8); } while (0)
#define SBA_STORE(bf) do { LAS unsigned char* kd_ = kdst + (bf) * KSB; *(LAS u32x4*)kd_ = kr0; *(LAS u32x4*)(kd_ + 16) = kr1; LAS unsigned char* vd_ = vdst + (bf) * VSB; \
        *(LAS u32x2*)vd_ = (u32x2){vr0.x, vr0.y}; *(LAS u32x2*)(vd_ + 8) = (u32x2){vr0.z, vr0.w}; *(LAS u32x2*)(vd_ + 16) = (u32x2){vr1.x, vr1.y}; *(LAS u32x2*)(vd_ + 24) = (u32x2){vr1.z, vr1.w}; } while (0)
    SBA_LOAD(jmax); SBA_STORE(0);
    __syncthreads();
    bool wdone = false;
    for (int j = jmax, it = 0;; --j, ++it) {
        const int buf = it & 1;
        if (j > 0) SBA_LOAD(j - 1);
        const int k0 = 64 * j;
        if (k0 < tw0 + 32 && !wdone) {
            const LAS unsigned char* kb = lds + OFF_K + buf * KSB + r32 * KP + hi * 16;
            f32x16 p0, p1;
#pragma unroll
            for (int r = 0; r < 16; ++r) { p0[r] = 0.f; p1[r] = 0.f; }
#pragma unroll
            for (int d0 = 0; d0 < 8; ++d0) {
                const bf16x8 k0f = *(const LAS bf16x8*)(kb + d0 * 32), k1f = *(const LAS bf16x8*)(kb + 32 * KP + d0 * 32);
                p0 = __builtin_amdgcn_mfma_f32_32x32x16_bf16(k0f, qr[d0], p0, 0, 0, 0);
                p1 = __builtin_amdgcn_mfma_f32_32x32x16_bf16(k1f, qr[d0], p1, 0, 0, 0);
            }
            const bool band = (k0 + 63 >= tw0);
            sb_block(p1, R, k0 + 32, trow, hi, band);
            sb_block(p0, R, k0, trow, hi, band);
            bf16x8 pw[4];
            { u32x4 w;
              w.x = cvtpk(p0[0], p0[1]); w.y = cvtpk(p0[2], p0[3]); w.z = cvtpk(p0[4], p0[5]); w.w = cvtpk(p0[6], p0[7]); pw[0] = __builtin_bit_cast(bf16x8, w);
              w.x = cvtpk(p0[8], p0[9]); w.y = cvtpk(p0[10], p0[11]); w.z = cvtpk(p0[12], p0[13]); w.w = cvtpk(p0[14], p0[15]); pw[1] = __builtin_bit_cast(bf16x8, w);
              w.x = cvtpk(p1[0], p1[1]); w.y = cvtpk(p1[2], p1[3]); w.z = cvtpk(p1[4], p1[5]); w.w = cvtpk(p1[6], p1[7]); pw[2] = __builtin_bit_cast(bf16x8, w);
              w.x = cvtpk(p1[8], p1[9]); w.y = cvtpk(p1[10], p1[11]); w.z = cvtpk(p1[12], p1[13]); w.w = cvtpk(p1[14], p1[15]); pw[3] = __builtin_bit_cast(bf16x8, w); }
            const LAS unsigned char* vb = lds + OFF_V + buf * VSB + r32 * VP + hi * 8;
            s16x4 va[4][2], vc[4][2];
#define SBA_VLD(dst, ks) do { _Pragma("unroll") for (int db = 0; db < 4; ++db) { dst[db][0] = *(const LAS s16x4*)(vb + db * 32 * VP + (ks) * 32); dst[db][1] = *(const LAS s16x4*)(vb + db * 32 * VP + (ks) * 32 + 16); } } while (0)
#define SBA_PV(src, ks) do { _Pragma("unroll") for (int db = 0; db < 4; ++db) { const bf16x8 vf = (bf16x8){src[db][0][0], src[db][0][1], src[db][0][2], src[db][0][3], src[db][1][0], src[db][1][1], src[db][1][2], src[db][1][3]}; \
                o[db] = __builtin_amdgcn_mfma_f32_32x32x16_bf16(pw[ks], vf, o[db], 0, 0, 0); } } while (0)
#define SBA_SB() __builtin_amdgcn_sched_barrier(0)
            SBA_VLD(va, 0); SBA_VLD(vc, 1); SBA_SB();
            SBA_PV(va, 0); SBA_SB(); SBA_VLD(va, 2); SBA_SB();
            SBA_PV(vc, 1); SBA_SB(); SBA_VLD(vc, 3); SBA_SB();
            SBA_PV(va, 2); SBA_SB();
            SBA_PV(vc, 3); SBA_SB();
#undef SBA_SB
#undef SBA_VLD
#undef SBA_PV
#if SBA_EARLY_EXIT
            wdone = __all(R > 1e30f);
#endif
        }
        if (j > 0) SBA_STORE(buf ^ 1);
        if (lane == 0) flags[buf * 8 + wid] = wdone ? 1u : 0u;
        __syncthreads();
        if (j == 0) break;
        unsigned nd = 0;
#pragma unroll
        for (int w = 0; w < 8; ++w) nd += flags[buf * 8 + w];
        if (nd == 8u) break;
    }
#undef SBA_LOAD
#undef SBA_STORE
    {
        const int erow = lane >> 4, ec = lane & 15;
        u32x4 sgv[8];
#pragma unroll
        for (int i = 0; i < 8; ++i) sgv[i] = *(const u32x4*)(SGb + (rowbase + tw0 + 4 * i + erow) * DM + h * HD + ec * 8);
        LAS unsigned char* stg = lds + wid * (32 * KP);
#pragma unroll
        for (int db = 0; db < 4; ++db)
#pragma unroll
            for (int r = 0; r < 16; r += 2) {
                const unsigned pk = cvtpk(o[db][r], o[db][r + 1]);
                *(LAS unsigned short*)(stg + crow(r, hi) * KP + (db * 32 + r32) * 2) = (unsigned short)(pk & 0xffffu);
                *(LAS unsigned short*)(stg + crow(r + 1, hi) * KP + (db * 32 + r32) * 2) = (unsigned short)(pk >> 16);
            }
        asm volatile("s_waitcnt lgkmcnt(0)" ::: "memory");
#pragma unroll
        for (int i = 0; i < 8; ++i) {
            const u32x4 ov = *(const LAS u32x4*)(stg + (4 * i + erow) * KP + ec * 16);
            u32x4 w;
#pragma unroll
            for (int j = 0; j < 4; ++j) w[j] = cvtpk(__uint_as_float(ov[j] << 16) * __uint_as_float(sgv[i][j] << 16), __uint_as_float(ov[j] & 0xffff0000u) * __uint_as_float(sgv[i][j] & 0xffff0000u));
            *(u32x4*)(OG + (rowbase + tw0 + 4 * i + erow) * DM + h * HD + ec * 8) = w;
        }
    }
    __syncthreads();
}
}

#ifndef MK_PH_LO
#define MK_PH_LO 0
#endif
#ifndef MK_PH_HI
#define MK_PH_HI 9
#endif
__global__ void __launch_bounds__(NWAVES * 64, 2) yoco_fwd(Params p) {
    extern __shared__ __attribute__((aligned(16))) unsigned char lds_raw[];
    LAS unsigned char* lds = (LAS unsigned char*)lds_raw;
    cg::grid_group grid = cg::this_grid();
    const int G = gridDim.x, bx = blockIdx.x;
    const int vcu = (G % 8 == 0) ? (bx % 8) * (G / 8) + bx / 8 : bx;
    unsigned char* ws = p.ws;
    bf16* W1T = (bf16*)(ws + WS_W1T); bf16* W2T = (bf16*)(ws + WS_W2T); bf16* W3T = (bf16*)(ws + WS_W3T); bf16* W4T = (bf16*)(ws + WS_W4T);

#ifndef PHMASK
#define PHMASK 0x1ff
#endif
#ifndef REPMASK
#define REPMASK 0
#endif
#define NREP(k) (((REPMASK) >> (k)) & 1 ? 2 : 1)
#define PH(k) for (int rep_ = 0; rep_ < NREP(k); ++rep_) if ((rep_ ? (grid.sync(), true) : true) && ((PHMASK >> (k)) & 1))
    PH(0) p0_phase(lds, p, G);
    grid.sync();
    PH(1) {
        pg8::Gemm g{(const bf16*)(ws + WS_XB), W1T, MROWS, 3 * AW, DM}; pg8::StaticOrder S; S.init(MROWS, 3 * AW, G, bx);
        pg8::EpiG1 E{(bf16*)(ws + WS_U), (size_t)(WS_GVT - WS_U) / 2, (float*)(ws + WS_ST), p.a_b_in};
        pg8::gemm_phase<pg8::EpiG1, pg8::StaticOrder, true, true>(lds, g, S, E);
    }
    grid.sync();
    PH(2) mix_phase(lds, p, bx, G);
    grid.sync();
    PH(3) {
        pg8::Gemm g{(const bf16*)(ws + WS_SM), W2T, MROWS, DM, AW}; pg8::StaticOrder S; S.init(MROWS, DM, G, bx);
        pg8::EpiRes E{p.x, (float*)(ws + WS_Z)};
        pg8::gemm_phase<pg8::EpiRes, pg8::StaticOrder, true, true>(lds, g, S, E);
    }
    grid.sync();
    PH(4) ln_phase((const float*)(ws + WS_Z), p.ln_g, p.ln_b, (float*)(ws + WS_X1), (bf16*)(ws + WS_X1B), G);
    grid.sync();
    PH(5) {
        pg8::Gemm g{(const bf16*)(ws + WS_X1B), W3T, MROWS, 4 * DM, DM}; pg8::StaticOrder S; S.init(MROWS, 4 * DM, G, bx);
        pg8::EpiG3 E{(bf16*)(ws + WS_KB), (size_t)(WS_VT - WS_KB) / 2};
        pg8::gemm_phase<pg8::EpiG3, pg8::StaticOrder, true, true>(lds, g, S, E);
    }
    grid.sync();
    PH(6) {
        for (int v = vcu; v < 256; v += G) {
            const int bh = v >> 3, s = v & 7;
            for (int i = 0; i < 2; ++i)
                sba::attn_unit(lds, bh >> 4, bh & 15, i == 0 ? 15 - s : s, (const bf16*)(ws + WS_QB), (const bf16*)(ws + WS_KB), (const bf16*)(ws + WS_VT), (const bf16*)(ws + WS_SGB), (bf16*)(ws + WS_OG));
        }
    }
    grid.sync();
    PH(7) {
        pg8::Gemm g{(const bf16*)(ws + WS_OG), W4T, MROWS, DM, DM}; pg8::StaticOrder S; S.init(MROWS, DM, G, bx);
        pg8::EpiRes E{(const float*)(ws + WS_X1), (float*)(ws + WS_Z2)};
        pg8::gemm_phase<pg8::EpiRes, pg8::StaticOrder, true, true>(lds, g, S, E);
    }
    grid.sync();
    PH(8) ln_phase((const float*)(ws + WS_Z2), p.ln_g + DM, p.ln_b + DM, p.out, nullptr, G);
}

extern "C" void kernel_launch(void* const* d_in, const int* in_sizes, int n_in, void* d_out, int out_size, void* d_ws, size_t ws_size, hipStream_t stream) {
    static int grid = 0;
    if (grid == 0) {
        if (n_in != 13 || in_sizes[0] != MROWS * DM || out_size != MROWS * DM || ws_size < WS_END) {
            fprintf(stderr, "kernel_launch: shape/workspace mismatch (n_in %d, in0 %d, out %d, ws %zu, need %zu)\n", n_in, n_in > 0 ? in_sizes[0] : -1, out_size, ws_size, (size_t)WS_END); grid = -1; return; }
        int dev = 0, cus = 0, per_cu = 0;
        hipGetDevice(&dev);
        hipDeviceGetAttribute(&cus, hipDeviceAttributeMultiprocessorCount, dev);
        if (hipFuncSetAttribute((const void*)yoco_fwd, hipFuncAttributeMaxDynamicSharedMemorySize, LDS_BYTES) != hipSuccess) { fprintf(stderr, "kernel_launch: hipFuncSetAttribute failed\n"); grid = -1; return; }
        if (hipOccupancyMaxActiveBlocksPerMultiprocessor(&per_cu, (const void*)yoco_fwd, NWAVES * 64, LDS_BYTES) != hipSuccess || per_cu < 1) { fprintf(stderr, "kernel_launch: occupancy query says %d\n", per_cu); per_cu = 1; }
        (void)hipGetLastError();
        grid = cus * (per_cu > 1 ? 1 : per_cu);
    }
    if (grid < 0) return;
    Params p{};
    p.x = (const float*)d_in[0]; p.a_w_in = (const float*)d_in[1]; p.a_b_in = (const float*)d_in[2]; p.a_vln_g = (const float*)d_in[3]; p.a_vln_b = (const float*)d_in[4];
    p.a_w_s = (const float*)d_in[5]; p.a_b_s = (const float*)d_in[6]; p.a_w_out = (const float*)d_in[7]; p.kv_w = (const float*)d_in[8]; p.b_w_in = (const float*)d_in[9];
    p.b_w_out = (const float*)d_in[10]; p.ln_g = (const float*)d_in[11]; p.ln_b = (const float*)d_in[12]; p.out = (float*)d_out; p.ws = (unsigned char*)d_ws;
    void* args[] = {&p};
    const hipError_t e = hipLaunchCooperativeKernel((const void*)yoco_fwd, dim3(grid), dim3(NWAVES * 64), args, LDS_BYTES, stream);
    if (e != hipSuccess) fprintf(stderr, "kernel_launch: cooperative launch failed: %s (grid %d)\n", hipGetErrorString(e), grid);
}
```
